# Optimizing an MI355X kernel written in HIP

```python
import math
import jax, jax.numpy as jnp
from jax import lax
import numpy as np

D_MODEL = 2048
BATCH = 4
SEQ = 2048
DEPTH = 4
DEC_BATCH = 128
DEC_SEQ = 4
PAST_LEN = 16384
PAGE_SIZE = 128

N_EVEN = (DEPTH + 1) // 2
N_ODD = DEPTH // 2
MIX_HALF = D_MODEL // 2
RET_HEADS = 4
RET_DK = MIX_HALF // RET_HEADS
RET_DV = MIX_HALF // RET_HEADS
RET_CHUNK = 128
ROPE_BASE = 10000.0
LRU_WIDTH = MIX_HALF
LRU_HEADS = 8
LRU_BLOCK = LRU_WIDTH // LRU_HEADS
LRU_C = 8.0
CONV_W = 4
IN_WIDTH = 6 * MIX_HALF
SSM_GROUP = 16
SSM_GROUPS = D_MODEL // SSM_GROUP
SSM_P = 64
SSM_CHUNK = 128
FFN_HIDDEN = ((8 * D_MODEL + 3 * 256 - 1) // (3 * 256)) * 256
EPS = 1e-6

kernel_name = 'hybrid_retention_rglru_s5_decode_step'


def rmsnorm(x, g):
    xf = x.astype(jnp.float32)
    y = xf * lax.rsqrt(jnp.mean(xf * xf, axis=-1, keepdims=True) + EPS)
    return (y * g.astype(jnp.float32)).astype(x.dtype)


def rotary(x, pos):
    half = x.shape[-1] // 2
    inv = 1.0 / jnp.power(ROPE_BASE, jnp.linspace(0.0, 1.0, half, dtype=jnp.float32))
    ang = pos.astype(jnp.float32)[:, None] * inv[None, :]
    cos = jnp.cos(ang)[None, :, None, :]
    sin = jnp.sin(ang)[None, :, None, :]
    x1, x2 = x[..., :half], x[..., half:]
    return jnp.concatenate([x1 * cos - x2 * sin, x2 * cos + x1 * sin], axis=-1)


def retention(q, k, v, s0, pos0):
    B, T, H, dk = q.shape
    C = math.gcd(T, RET_CHUNK)
    NC = T // C
    pos = pos0 + jnp.arange(T)
    qf = rotary(q.astype(jnp.float32), pos)
    kf = rotary(k.astype(jnp.float32), pos) * (dk ** -0.5)
    vf = v.astype(jnp.float32)
    log_g = jnp.log1p(-jnp.exp2(-5.0 - jnp.arange(H, dtype=jnp.float32)))
    idx = jnp.arange(C, dtype=jnp.float32)
    diff = idx[:, None] - idx[None, :]
    mask = jnp.where(diff[None] >= 0, jnp.exp(jnp.maximum(diff, 0.0)[None] * log_g[:, None, None]), 0.0)
    q_dec = jnp.exp((idx[:, None] + 1.0) * log_g[None, :])
    k_dec = jnp.exp((C - 1.0 - idx)[:, None] * log_g[None, :])
    chunk_dec = jnp.exp(C * log_g)

    def to_chunks(a):
        return a.reshape(B, NC, C, H, a.shape[-1]).swapaxes(0, 1)

    def step(s, inp):
        qc, kc, vc = inp
        scores = jnp.einsum('bnhd,bmhd->bhnm', qc, kc) * mask
        o = (jnp.einsum('bhnm,bmhe->bnhe', scores, vc)
             + jnp.einsum('bnhd,bhde->bnhe', qc, s) * q_dec[None, :, :, None])
        s = (s * chunk_dec[None, :, None, None]
             + jnp.einsum('bmhd,bmhe->bhde', kc * k_dec[None, :, :, None], vc))
        return s, o

    s, o = lax.scan(step, s0.astype(jnp.float32), (to_chunks(qf), to_chunks(kf), to_chunks(vf)))
    o = o.swapaxes(0, 1).reshape(B, T, H, vf.shape[-1])
    return o, s


def causal_conv(x, buf, w, b):
    T = x.shape[1]
    xp = jnp.concatenate([buf.astype(jnp.float32), x.astype(jnp.float32)], axis=1)
    wf = w.astype(jnp.float32)
    y = b.astype(jnp.float32) + sum(xp[:, i:i + T] * wf[i] for i in range(CONV_W))
    new_buf = xp[:, xp.shape[1] - (CONV_W - 1):]
    return y, new_buf


def _lin_combine(e1, e2):
    a1, b1 = e1
    a2, b2 = e2
    return a1 * a2, a2 * b1 + b2


def rglru(x, h0, wa, ba, wx, bx, lam):
    B, T, W = x.shape
    xb = x.reshape(B, T, LRU_HEADS, LRU_BLOCK)
    r = jax.nn.sigmoid(jnp.einsum('btnk,nkj->btnj', xb, wa.astype(jnp.float32)).reshape(B, T, W) + ba.astype(jnp.float32))
    i = jax.nn.sigmoid(jnp.einsum('btnk,nkj->btnj', xb, wx.astype(jnp.float32)).reshape(B, T, W) + bx.astype(jnp.float32))
    log_a = -LRU_C * r * jax.nn.softplus(-lam.astype(jnp.float32))
    a = jnp.exp(log_a)
    mult = jnp.sqrt(jnp.maximum(-jnp.expm1(2.0 * log_a), 0.0))
    bterm = mult * i * x
    bterm = bterm.at[:, 0].add(a[:, 0] * h0.astype(jnp.float32))
    _, h = lax.associative_scan(_lin_combine, (a, bterm), axis=1)
    return h, h[:, -1]


def _cplx_combine(e1, e2):
    ar1, ai1, br1, bi1 = e1
    ar2, ai2, br2, bi2 = e2
    return (ar2 * ar1 - ai2 * ai1, ar2 * ai1 + ai2 * ar1,
            ar2 * br1 - ai2 * bi1 + br2, ar2 * bi1 + ai2 * br1 + bi2)


def s5(u, h0_re, h0_im, a_re, a_im, b_re, b_im, c_re, c_im, d, log_dt):
    B, T, Dm = u.shape
    f32 = jnp.float32
    uf = u.astype(f32)
    a_re, a_im = a_re.astype(f32), a_im.astype(f32)
    dt = jnp.exp(log_dt.astype(f32))[:, None]
    mag = jnp.exp(a_re * dt)
    abr = mag * jnp.cos(a_im * dt)
    abi = mag * jnp.sin(a_im * dt)
    den = a_re * a_re + a_im * a_im
    nr, ni = abr - 1.0, abi
    fr = (nr * a_re + ni * a_im) / den
    fi = (ni * a_re - nr * a_im) / den
    b_re, b_im = b_re.astype(f32), b_im.astype(f32)
    bbr = fr[..., None] * b_re - fi[..., None] * b_im
    bbi = fr[..., None] * b_im + fi[..., None] * b_re
    c_re, c_im = c_re.astype(f32), c_im.astype(f32)
    C = math.gcd(T, SSM_CHUNK)
    NC = T // C
    abr_c = jnp.broadcast_to(abr, (B, C, SSM_GROUPS, SSM_P))
    abi_c = jnp.broadcast_to(abi, (B, C, SSM_GROUPS, SSM_P))

    def step(carry, uc):
        hr, hi = carry
        bu_r = jnp.einsum('bcgk,gpk->bcgp', uc, bbr)
        bu_i = jnp.einsum('bcgk,gpk->bcgp', uc, bbi)
        bu_r = bu_r.at[:, 0].add(abr * hr - abi * hi)
        bu_i = bu_i.at[:, 0].add(abr * hi + abi * hr)
        _, _, sr, si = lax.associative_scan(_cplx_combine, (abr_c, abi_c, bu_r, bu_i), axis=1)
        y = jnp.einsum('bcgp,gkp->bcgk', sr, c_re) - jnp.einsum('bcgp,gkp->bcgk', si, c_im)
        return (sr[:, -1], si[:, -1]), y

    uc_all = uf.reshape(B, NC, C, SSM_GROUPS, SSM_GROUP).swapaxes(0, 1)
    (hr, hi), y = lax.scan(step, (h0_re.astype(f32), h0_im.astype(f32)), uc_all)
    y = y.swapaxes(0, 1).reshape(B, T, Dm) + d.astype(f32) * uf
    return y, hr, hi


def swiglu(x, w_gu, w_down):
    h = x @ w_gu
    g, u = jnp.split(h, 2, axis=-1)
    return (jax.nn.silu(g) * u) @ w_down


def even_mixer(x, s_ret0, h0, conv0, pos0, g, w_in, conv_w, conv_b, wa, ba, wx, bx, lam, w_out):
    B, T, _ = x.shape
    proj = rmsnorm(x, g) @ w_in
    q, k, v, gr, xl, yl = jnp.split(proj, 6, axis=-1)
    q = q.reshape(B, T, RET_HEADS, RET_DK)
    k = k.reshape(B, T, RET_HEADS, RET_DK)
    v = v.reshape(B, T, RET_HEADS, RET_DV)
    o, s_ret = retention(q, k, v, s0=s_ret0, pos0=pos0)
    o = o * lax.rsqrt(jnp.mean(o * o, axis=-1, keepdims=True) + EPS)
    o = o.reshape(B, T, RET_HEADS * RET_DV) * jax.nn.silu(gr.astype(jnp.float32))
    xc, conv_new = causal_conv(xl, conv0, conv_w, conv_b)
    hs, h_last = rglru(xc, h0, wa, ba, wx, bx, lam)
    lo = jax.nn.gelu(yl.astype(jnp.float32)) * hs
    out = jnp.concatenate([o, lo], axis=-1).astype(x.dtype) @ w_out
    return out, s_ret, h_last, conv_new


def odd_mixer(x, h0_re, h0_im, g, a_re, a_im, b_re, b_im, c_re, c_im, d, log_dt, w_glu, b_glu):
    u = rmsnorm(x, g)
    y, hr, hi = s5(u, h0_re, h0_im, a_re, a_im, b_re, b_im, c_re, c_im, d, log_dt)
    y = jax.nn.gelu(y).astype(x.dtype)
    z = y @ w_glu + b_glu
    z1, z2 = jnp.split(z, 2, axis=-1)
    return z1 * jax.nn.sigmoid(z2), hr, hi


def setup_inputs(seed: int = 0) -> dict:
    key = jax.random.key(seed)
    ks = iter(jax.random.split(key, 40))
    f32 = jnp.float32

    def nrm(shape, scale):
        return jax.random.normal(next(ks), shape, f32) * scale

    def gain(shape):
        return 1.0 + nrm(shape, 0.02)

    x_prompt = nrm((BATCH, SEQ, D_MODEL), 1.0)
    x_sample = nrm((DEC_BATCH, DEC_SEQ, D_MODEL), 1.0)
    state_ret = nrm((N_EVEN, DEC_BATCH, RET_HEADS, RET_DK, RET_DV), 0.1)
    state_lru = nrm((N_EVEN, DEC_BATCH, LRU_WIDTH), 0.5)
    state_conv = nrm((N_EVEN, DEC_BATCH, CONV_W - 1, LRU_WIDTH), 1.0)
    state_ssm_re = nrm((N_ODD, DEC_BATCH, SSM_GROUPS, SSM_P), 0.1)
    state_ssm_im = nrm((N_ODD, DEC_BATCH, SSM_GROUPS, SSM_P), 0.1)
    norm_mix_even = gain((N_EVEN, D_MODEL))
    w_in_even = nrm((N_EVEN, D_MODEL, IN_WIDTH), D_MODEL ** -0.5)
    lru_conv_w = nrm((N_EVEN, CONV_W, LRU_WIDTH), CONV_W ** -0.5)
    lru_conv_b = nrm((N_EVEN, LRU_WIDTH), 0.01)
    lru_wa = nrm((N_EVEN, LRU_HEADS, LRU_BLOCK, LRU_BLOCK), LRU_BLOCK ** -0.5)
    lru_ba = nrm((N_EVEN, LRU_WIDTH), 0.01)
    lru_wx = nrm((N_EVEN, LRU_HEADS, LRU_BLOCK, LRU_BLOCK), LRU_BLOCK ** -0.5)
    lru_bx = nrm((N_EVEN, LRU_WIDTH), 0.01)
    a_pow = jax.random.uniform(next(ks), (N_EVEN, LRU_WIDTH), f32, 0.9, 0.999)
    s = a_pow ** (1.0 / LRU_C)
    lru_lambda = jnp.log(s) - jnp.log1p(-s)
    w_out_even = nrm((N_EVEN, 2 * MIX_HALF, D_MODEL), (2 * MIX_HALF) ** -0.5)
    norm_mix_odd = gain((N_ODD, D_MODEL))
    ssm_a_re = -0.5 + nrm((N_ODD, SSM_GROUPS, SSM_P), 0.01)
    ssm_a_im = math.pi * jnp.arange(SSM_P, dtype=f32) + nrm((N_ODD, SSM_GROUPS, SSM_P), 0.01)
    ssm_b_re = nrm((N_ODD, SSM_GROUPS, SSM_P, SSM_GROUP), (2 * SSM_GROUP) ** -0.5)
    ssm_b_im = nrm((N_ODD, SSM_GROUPS, SSM_P, SSM_GROUP), (2 * SSM_GROUP) ** -0.5)
    ssm_c_re = nrm((N_ODD, SSM_GROUPS, SSM_GROUP, SSM_P), SSM_P ** -0.5)
    ssm_c_im = nrm((N_ODD, SSM_GROUPS, SSM_GROUP, SSM_P), SSM_P ** -0.5)
    ssm_d = nrm((N_ODD, D_MODEL), 0.5)
    ssm_log_dt = jax.random.uniform(next(ks), (N_ODD, SSM_GROUPS), f32, math.log(1e-3), math.log(1e-1))
    w_glu = nrm((N_ODD, D_MODEL, 2 * D_MODEL), D_MODEL ** -0.5)
    b_glu = nrm((N_ODD, 2 * D_MODEL), 0.01)
    norm_ffn = gain((DEPTH, D_MODEL))
    w_ffn_gu = nrm((DEPTH, D_MODEL, 2 * FFN_HIDDEN), D_MODEL ** -0.5)
    w_ffn_down = nrm((DEPTH, FFN_HIDDEN, D_MODEL), FFN_HIDDEN ** -0.5)
    norm_final = gain((D_MODEL,))
    return {
        'x_prompt': x_prompt, 'x_sample': x_sample,
        'state_ret': state_ret, 'state_lru': state_lru, 'state_conv': state_conv,
        'state_ssm_re': state_ssm_re, 'state_ssm_im': state_ssm_im,
        'norm_mix_even': norm_mix_even, 'w_in_even': w_in_even,
        'lru_conv_w': lru_conv_w, 'lru_conv_b': lru_conv_b,
        'lru_wa': lru_wa, 'lru_ba': lru_ba, 'lru_wx': lru_wx, 'lru_bx': lru_bx,
        'lru_lambda': lru_lambda, 'w_out_even': w_out_even,
        'norm_mix_odd': norm_mix_odd, 'ssm_a_re': ssm_a_re, 'ssm_a_im': ssm_a_im,
        'ssm_b_re': ssm_b_re, 'ssm_b_im': ssm_b_im, 'ssm_c_re': ssm_c_re, 'ssm_c_im': ssm_c_im,
        'ssm_d': ssm_d, 'ssm_log_dt': ssm_log_dt, 'w_glu': w_glu, 'b_glu': b_glu,
        'norm_ffn': norm_ffn, 'w_ffn_gu': w_ffn_gu, 'w_ffn_down': w_ffn_down,
        'norm_final': norm_final,
    }


def reference(x_prompt, x_sample, state_ret, state_lru, state_conv, state_ssm_re, state_ssm_im,
              norm_mix_even, w_in_even, lru_conv_w, lru_conv_b, lru_wa, lru_ba, lru_wx, lru_bx,
              lru_lambda, w_out_even, norm_mix_odd, ssm_a_re, ssm_a_im, ssm_b_re, ssm_b_im,
              ssm_c_re, ssm_c_im, ssm_d, ssm_log_dt, w_glu, b_glu, norm_ffn, w_ffn_gu, w_ffn_down,
              norm_final):
    def trunk(x, ret0, lru0, conv0, sre0, sim0, pos0):
        rets, lrus, convs, sres, sims = [], [], [], [], []
        for layer in range(DEPTH):
            if layer % 2 == 0:
                e = layer // 2
                out, s_r, s_l, s_c = even_mixer(
                    x, ret0[e], lru0[e], conv0[e], pos0, norm_mix_even[e], w_in_even[e],
                    lru_conv_w[e], lru_conv_b[e], lru_wa[e], lru_ba[e], lru_wx[e], lru_bx[e],
                    lru_lambda[e], w_out_even[e])
                rets.append(s_r)
                lrus.append(s_l)
                convs.append(s_c)
            else:
                o = layer // 2
                out, s_re, s_im = odd_mixer(
                    x, sre0[o], sim0[o], norm_mix_odd[o], ssm_a_re[o], ssm_a_im[o], ssm_b_re[o],
                    ssm_b_im[o], ssm_c_re[o], ssm_c_im[o], ssm_d[o], ssm_log_dt[o], w_glu[o], b_glu[o])
                sres.append(s_re)
                sims.append(s_im)
            x = x + out.astype(x.dtype)
            x = x + swiglu(rmsnorm(x, norm_ffn[layer]), w_ffn_gu[layer], w_ffn_down[layer])
        y = rmsnorm(x, norm_final)
        return (y,
                jnp.stack(rets).astype(state_ret.dtype),
                jnp.stack(lrus).astype(state_lru.dtype),
                jnp.stack(convs).astype(state_conv.dtype),
                jnp.stack(sres).astype(state_ssm_re.dtype),
                jnp.stack(sims).astype(state_ssm_im.dtype))

    bp = x_prompt.shape[0]
    ret0_p = jnp.zeros((N_EVEN, bp, RET_HEADS, RET_DK, RET_DV), state_ret.dtype)
    lru0_p = jnp.zeros((N_EVEN, bp, LRU_WIDTH), state_lru.dtype)
    conv0_p = jnp.zeros((N_EVEN, bp, CONV_W - 1, LRU_WIDTH), state_conv.dtype)
    sre0_p = jnp.zeros((N_ODD, bp, SSM_GROUPS, SSM_P), state_ssm_re.dtype)
    sim0_p = jnp.zeros((N_ODD, bp, SSM_GROUPS, SSM_P), state_ssm_im.dtype)

    y_prompt, ret_p, lru_p, conv_p, ssm_re_p, ssm_im_p = trunk(
        x_prompt, ret0_p, lru0_p, conv0_p, sre0_p, sim0_p, 0)
    y_sample, ret_s, lru_s, conv_s, ssm_re_s, ssm_im_s = trunk(
        x_sample, state_ret, state_lru, state_conv, state_ssm_re, state_ssm_im, PAST_LEN)
    return (y_prompt, y_sample, ret_p, ret_s, lru_p, lru_s, conv_p, conv_s,
            ssm_re_p, ssm_re_s, ssm_im_p, ssm_im_s)
```

```cpp
#include <hip/hip_runtime.h>
#include <cstdio>
#include <cstdint>
#define MK_ONE_LAUNCH 1
namespace pg8 {
#define PG8_LAS __attribute__((address_space(3)))
#define PG8_GAS __attribute__((address_space(1)))
typedef unsigned short __attribute__((may_alias)) bf16_t;
typedef short bf16x8 __attribute__((ext_vector_type(8), may_alias));
typedef float f32x4 __attribute__((ext_vector_type(4), may_alias));
typedef unsigned u32x4 __attribute__((ext_vector_type(4), may_alias));
constexpr int BM = 256, BK = 64, HALF = 128, HTB = HALF * BK * 2  , STAGE_BYTES = 8 * HTB, NXCD = 8, WGM = 8;

__host__ __device__ __forceinline__ int lds_byte(int r, int c) { const int st = (r >> 4) * 2 + (c >> 5), rr = r & 15, cc = c & 31, ob = rr * 64 + cc * 2; return st * 1024 + (ob ^ (((ob >> 9) & 1) << 5)); }
__host__ __device__ __forceinline__ void stage_rc(int b, int& R, int& C) { const int st = b / 1024, sb = b % 1024, swz = sb ^ (((sb >> 9) & 1) << 5); R = (st >> 1) * 16 + swz / 64; C = (st & 1) * 32 + (swz % 64) / 2; }
__host__ __device__ __forceinline__ int perm32(int rho) { const int n = rho >> 4, i = rho & 15; return 8 * (i >> 2) + 4 * n + (i & 3); }

struct Unit { int pm, pn, k0, nt, slice; };
struct Gemm { const PG8_GAS bf16_t* A; const PG8_GAS bf16_t* Bt; int M, N, K; };

struct StaticOrder {
    int nM, nN, nwg, G, c, ntk;
    __host__ __device__ void init(int M, int N, int G_, int c_, int ntk_) { nM = M / BM; nN = N / BM; nwg = nM * nN; G = G_; c = c_; ntk = ntk_; }
    __host__ __device__ bool next(int i, Unit& u) const {
        const long L = (long)i * G + c; if (L >= nwg) return false;
        int wgid = (int)L; { const int q = nwg / NXCD, r = nwg % NXCD, xcd = wgid % NXCD, off = wgid / NXCD; wgid = (xcd < r ? xcd * (q + 1) : r * (q + 1) + (xcd - r) * q) + off; }
        const int nig = WGM * nN, gid = wgid / nig, fm = gid * WGM, gsz = (nM - fm) < WGM ? (nM - fm) : WGM;
        u.pm = fm + ((wgid % nig) % gsz); u.pn = (wgid % nig) / gsz; u.k0 = 0; u.nt = ntk; u.slice = -1; return true;
    }
    __device__ __forceinline__ void a_ready(const Unit&) const {}
    __device__ __forceinline__ void done(const Unit&) const {}
};

struct TailOrder {
    StaticOrder main; int nN, S, nts, ntail, pm0;
    __host__ __device__ void init(int Mmain, int ntail_m, int N, int G_, int c_, int ntk, int S_) { main.init(Mmain, N, G_, c_, ntk); nN = N / BM; S = S_; nts = ntk / S_; ntail = ntail_m * nN * S_; pm0 = Mmain / BM; }
    __host__ __device__ bool next(int i, Unit& u) const {
        const long L = (long)i * main.G + main.c;
        if (L < main.nwg) return main.next(i, u);
        const int j = (int)(L - main.nwg); if (j >= ntail) return false;
        const int tile = j / S, sl = j - tile * S;
        u.pm = pm0 + (tile & 1); u.pn = tile >> 1; u.k0 = sl * nts * BK; u.nt = nts; u.slice = sl; return true;
    }
    __device__ __forceinline__ void a_ready(const Unit&) const {}
    __device__ __forceinline__ void done(const Unit&) const {}
};
typedef __bf16 bf16v2_ __attribute__((ext_vector_type(2))); typedef float f32v2_ __attribute__((ext_vector_type(2)));
__device__ __forceinline__ unsigned cvt_pk_bf16(float lo, float hi) { const f32v2_ v = {lo, hi}; return __builtin_bit_cast(unsigned, __builtin_convertvector(v, bf16v2_)); }
typedef float f32x2 __attribute__((ext_vector_type(2)));
__device__ __forceinline__ float fast_sigmoid(float x) { return __builtin_amdgcn_rcpf(1.0f + __builtin_amdgcn_exp2f(-1.44269504f * x)); }
struct EpiStoreBf16 {
    static constexpr bool PERM = true, AFTER_DRAIN = false;
    PG8_GAS bf16_t* O; int ldc;
    __device__ __forceinline__ void operator()(const f32x4 (&acc)[2][2][4][2], const Unit& u, int wr, int wc, int fr, int fq) const {
        const int row0 = u.pm * BM + wr * 64 + fr, col0 = u.pn * BM + wc * 32 + 8 * fq;
#pragma unroll
        for (int ai = 0; ai < 2; ++ai)
#pragma unroll
            for (int m = 0; m < 4; ++m) { PG8_GAS bf16_t* rowp = O + (size_t)(row0 + ai * HALF + m * 16) * ldc + col0;
#pragma unroll
                for (int bj = 0; bj < 2; ++bj) { const f32x4 v0 = acc[ai][bj][m][0], v1 = acc[ai][bj][m][1];
                    u32x4 w; w.x = cvt_pk_bf16(v0[0], v0[1]); w.y = cvt_pk_bf16(v0[2], v0[3]); w.z = cvt_pk_bf16(v1[0], v1[1]); w.w = cvt_pk_bf16(v1[2], v1[3]);
                    *(PG8_GAS u32x4*)(rowp + bj * HALF) = w; } }
    }
};
struct EpiResid {
    static constexpr bool PERM = false, AFTER_DRAIN = false;
    PG8_GAS float* X; int ldc; PG8_GAS float* slab; int row_base, slab_rows;
    __device__ __forceinline__ void operator()(const f32x4 (&acc)[2][2][4][2], const Unit& u, int wr, int wc, int fr, int fq) const {
        const int row0 = u.pm * BM + wr * 64 + fr, col0 = u.pn * BM + wc * 32 + 4 * fq;
        if (u.slice >= 0) {
            PG8_GAS float* sb = slab + ((size_t)u.slice * slab_rows + (row0 - row_base)) * ldc + col0;
#pragma unroll
            for (int ai = 0; ai < 2; ++ai)
#pragma unroll
                for (int m = 0; m < 4; ++m) { PG8_GAS float* rowp = sb + (size_t)(ai * HALF + m * 16) * ldc;
#pragma unroll
                    for (int bj = 0; bj < 2; ++bj)
#pragma unroll
                        for (int n = 0; n < 2; ++n) *(PG8_GAS f32x4*)(rowp + bj * HALF + n * 16) = acc[ai][bj][m][n]; }
            return;
        }
#pragma unroll
        for (int ai = 0; ai < 2; ++ai)
#pragma unroll
            for (int m = 0; m < 4; ++m) { PG8_GAS float* rowp = X + (size_t)(row0 + ai * HALF + m * 16) * ldc + col0;
                f32x4 b[2][2];
#pragma unroll
                for (int bj = 0; bj < 2; ++bj)
#pragma unroll
                    for (int n = 0; n < 2; ++n) b[bj][n] = *(const PG8_GAS f32x4*)(rowp + bj * HALF + n * 16);
#pragma unroll
                for (int bj = 0; bj < 2; ++bj)
#pragma unroll
                    for (int n = 0; n < 2; ++n) *(PG8_GAS f32x4*)(rowp + bj * HALF + n * 16) = b[bj][n] + acc[ai][bj][m][n];
                if (m == 3) asm volatile("" ::: "memory"); }
    }
};
struct EpiSwiglu {
    static constexpr bool PERM = true, AFTER_DRAIN = false;
    PG8_GAS bf16_t* H; int ldh;
    __device__ __forceinline__ void operator()(const f32x4 (&acc)[2][2][4][2], const Unit& u, int wr, int wc, int fr, int fq) const {
        const int row0 = u.pm * BM + wr * 64 + fr, col0 = u.pn * HALF + wc * 32 + 8 * fq;
#pragma unroll
        for (int ai = 0; ai < 2; ++ai)
#pragma unroll
            for (int m = 0; m < 4; ++m) { PG8_GAS bf16_t* rowp = H + (size_t)(row0 + ai * HALF + m * 16) * ldh + col0;
                f32x4 v[2];
#pragma unroll
                for (int n = 0; n < 2; ++n) { const f32x4 g = acc[ai][0][m][n], uu = acc[ai][1][m][n];
#pragma unroll
                    for (int j = 0; j < 4; ++j) v[n][j] = g[j] * fast_sigmoid(g[j]) * uu[j]; }
                u32x4 w; w.x = cvt_pk_bf16(v[0][0], v[0][1]); w.y = cvt_pk_bf16(v[0][2], v[0][3]); w.z = cvt_pk_bf16(v[1][0], v[1][1]); w.w = cvt_pk_bf16(v[1][2], v[1][3]);
                *(PG8_GAS u32x4*)rowp = w; }
    }
};
struct EpiGluResid {
    static constexpr bool PERM = false, AFTER_DRAIN = false;
    PG8_GAS float* X; int ldc; const PG8_GAS float* bias; int nhalf; PG8_GAS float* slab; int row_base, slab_rows;
    __device__ __forceinline__ void operator()(const f32x4 (&acc)[2][2][4][2], const Unit& u, int wr, int wc, int fr, int fq) const {
        const int row0 = u.pm * BM + wr * 64 + fr;
        if (u.slice >= 0) {
            PG8_GAS float* sb = slab + ((size_t)u.slice * slab_rows + (row0 - row_base)) * (2 * ldc) + u.pn * BM + wc * 32 + 4 * fq;
#pragma unroll
            for (int ai = 0; ai < 2; ++ai)
#pragma unroll
                for (int m = 0; m < 4; ++m) { PG8_GAS float* rowp = sb + (size_t)(ai * HALF + m * 16) * (2 * ldc);
#pragma unroll
                    for (int bj = 0; bj < 2; ++bj)
#pragma unroll
                        for (int n = 0; n < 2; ++n) *(PG8_GAS f32x4*)(rowp + bj * HALF + n * 16) = acc[ai][bj][m][n]; }
            return;
        }
        const int col0 = u.pn * HALF + wc * 32 + 4 * fq;
        f32x4 b1[2], b2[2];
#pragma unroll
        for (int n = 0; n < 2; ++n) { b1[n] = *(const PG8_GAS f32x4*)(bias + col0 + n * 16); b2[n] = *(const PG8_GAS f32x4*)(bias + nhalf + col0 + n * 16); }
#pragma unroll
        for (int ai = 0; ai < 2; ++ai)
#pragma unroll
            for (int m = 0; m < 4; ++m) { PG8_GAS float* rowp = X + (size_t)(row0 + ai * HALF + m * 16) * ldc + col0;
#pragma unroll
                for (int n = 0; n < 2; ++n) { const f32x4 z1 = acc[ai][0][m][n] + b1[n], z2 = acc[ai][1][m][n] + b2[n]; f32x4 o = *(const PG8_GAS f32x4*)(rowp + n * 16);
#pragma unroll
                    for (int j = 0; j < 4; ++j) o[j] += z1[j] * fast_sigmoid(z2[j]);
                    *(PG8_GAS f32x4*)(rowp + n * 16) = o; }
                if (m == 3) asm volatile("" ::: "memory"); }
    }
};
template <class Epi, class Sched, bool ALIGN_EPI = false, bool SP2 = false>
__device__ __forceinline__ void gemm_phase(PG8_LAS unsigned char* lds, const Gemm g, const Sched& S, const Epi& E, int tid_in) {
    int tid_ = tid_in; asm volatile("" : "+v"(tid_));
    const int tid = tid_, wid = __builtin_amdgcn_readfirstlane(tid >> 6), lane = tid & 63, wr = wid >> 2, wc = wid & 3, fr = lane & 15, fq = lane >> 4;
    const int K = g.K;
    unsigned voffA[2], voffB[2];
#pragma unroll
    for (int i = 0; i < 2; ++i) { int R, C; stage_rc(tid * 16 + i * 8192, R, C); const int Rb = Epi::PERM ? ((R & ~31) + perm32(R & 31)) : R;
        voffA[i] = (unsigned)(R * K + C) * 2u; voffB[i] = (unsigned)(Rb * K + C) * 2u; }
    const size_t kstep = (size_t)(BK * 2);
    const size_t hstep = (size_t)HALF * K * 2;
    const size_t tstep = 2 * hstep;
    const unsigned ldsw = (unsigned)wid * 1024u;
    const int aoff = lds_byte(wr * 64 + fr, fq * 8), boff = lds_byte(wc * 32 + fr, fq * 8);
#define PG8_SA(b, h) (((b) * 2 + (h)) * HTB)
#define PG8_SB(b, h) ((4 + (b) * 2 + (h)) * HTB)
#define PG8_STAGE(bufoff, gbase, voff) do { _Pragma("unroll") for (int _i = 0; _i < 2; ++_i) \
        __builtin_amdgcn_global_load_lds((const PG8_GAS unsigned*)((const PG8_GAS char*)(gbase) + (voff)[_i]), (PG8_LAS unsigned*)(lds + (bufoff) + ldsw + _i * 8192), 16, 0, 0); } while (0)
#define PG8_LDA(dst, b, h) do { _Pragma("unroll") for (int m = 0; m < 4; ++m) _Pragma("unroll") for (int k = 0; k < 2; ++k) dst[m][k] = *(const PG8_LAS bf16x8*)(lds + PG8_SA(b, h) + aoff + m * 2048 + k * 1024); } while (0)
#define PG8_LDB(dst, b, h) do { _Pragma("unroll") for (int n = 0; n < 2; ++n) _Pragma("unroll") for (int k = 0; k < 2; ++k) dst[n][k] = *(const PG8_LAS bf16x8*)(lds + PG8_SB(b, h) + boff + n * 2048 + k * 1024); } while (0)
#define PG8_MMA(ai, bj, At, Bt) do { __builtin_amdgcn_s_setprio(1); _Pragma("unroll") for (int m = 0; m < 4; ++m) _Pragma("unroll") for (int n = 0; n < 2; ++n) _Pragma("unroll") for (int k = 0; k < 2; ++k) \
        acc[ai][bj][m][n] = __builtin_amdgcn_mfma_f32_16x16x32_bf16(Bt[n][k], At[m][k], acc[ai][bj][m][n], 0, 0, 0); __builtin_amdgcn_s_setprio(0); } while (0)
#define PG8_WAIT_V(n) asm volatile("s_waitcnt vmcnt(" #n ")" ::: "memory")
#define PG8_WAIT_L(n) asm volatile("s_waitcnt lgkmcnt(" #n ")" ::: "memory")
#define PG8_BAR __builtin_amdgcn_s_barrier()
#define PG8_SCHED __builtin_amdgcn_sched_barrier(0)
    Unit cur, nxt; int ui = 0;
    if (!S.next(0, cur)) return;
    f32x4 acc[2][2][4][2];
#pragma unroll
    for (int a = 0; a < 2; ++a)
#pragma unroll
        for (int b = 0; b < 2; ++b)
#pragma unroll
            for (int m = 0; m < 4; ++m)
#pragma unroll
                for (int n = 0; n < 2; ++n) acc[a][b][m][n] = (f32x4){0.f, 0.f, 0.f, 0.f};
    bf16x8 At[4][2], B0[2][2], B1[2][2];
    const PG8_GAS char* cA = (const PG8_GAS char*)g.A + (size_t)cur.pm * tstep + (size_t)cur.k0 * 2; const PG8_GAS char* cB = (const PG8_GAS char*)g.Bt + (size_t)cur.pn * tstep + (size_t)cur.k0 * 2;
    S.a_ready(cur);
    if constexpr (SP2) {
        PG8_STAGE(PG8_SB(0, 0), cB, voffB); PG8_STAGE(PG8_SB(0, 1), cB + hstep, voffB); PG8_STAGE(PG8_SA(0, 0), cA, voffA); PG8_STAGE(PG8_SA(0, 1), cA + hstep, voffA);
        if (wr == 1) PG8_BAR;
        PG8_WAIT_V(2); PG8_BAR;
        PG8_STAGE(PG8_SB(1, 0), cB + kstep, voffB); PG8_STAGE(PG8_SA(1, 0), cA + kstep, voffA); PG8_STAGE(PG8_SB(1, 1), cB + hstep + kstep, voffB);
        PG8_WAIT_V(6); PG8_BAR;
    } else {
        PG8_STAGE(PG8_SB(0, 0), cB, voffB); PG8_STAGE(PG8_SA(0, 0), cA, voffA); PG8_STAGE(PG8_SB(0, 1), cB + hstep, voffB); PG8_STAGE(PG8_SA(0, 1), cA + hstep, voffA);
        if (wr == 1) PG8_BAR;
        PG8_WAIT_V(4); PG8_BAR;
        PG8_STAGE(PG8_SB(1, 0), cB + kstep, voffB); PG8_STAGE(PG8_SA(1, 0), cA + kstep, voffA); PG8_STAGE(PG8_SB(1, 1), cB + hstep + kstep, voffB);
        PG8_WAIT_V(6); PG8_BAR;
    }
    for (;;) {
        const bool has_next = S.next(ui + 1, nxt);
        const PG8_GAS char* nA = has_next ? (const PG8_GAS char*)g.A + (size_t)nxt.pm * tstep + (size_t)nxt.k0 * 2 : cA; const PG8_GAS char* nB = has_next ? (const PG8_GAS char*)g.Bt + (size_t)nxt.pn * tstep + (size_t)nxt.k0 * 2 : cB;
        const int nt = cur.nt;
        for (int t = 0; t < nt; t += 2) {
            const bool last = (t == nt - 2);
            const PG8_GAS char* a1 = cA + (size_t)(t + 1) * kstep;
            const PG8_GAS char* a2 = last ? nA : cA + (size_t)(t + 2) * kstep; const PG8_GAS char* b2 = last ? nB : cB + (size_t)(t + 2) * kstep;
            const PG8_GAS char* a3 = a2 + kstep; const PG8_GAS char* b3 = b2 + kstep;
            if (last && has_next) S.a_ready(nxt);
            if constexpr (SP2) {
            PG8_LDB(B0, 0, 0); PG8_LDB(B1, 0, 1); PG8_SCHED; PG8_LDA(At, 0, 0); PG8_STAGE(PG8_SA(1, 1), a1 + hstep, voffA);
            PG8_WAIT_V(8); PG8_WAIT_L(0); PG8_BAR; PG8_MMA(0, 0, At, B0); PG8_MMA(0, 1, At, B1); PG8_BAR; PG8_SCHED;
            PG8_LDA(At, 0, 1); PG8_STAGE(PG8_SB(0, 0), b2, voffB); PG8_STAGE(PG8_SB(0, 1), b2 + hstep, voffB); PG8_STAGE(PG8_SA(0, 0), a2, voffA);
            PG8_WAIT_V(8); PG8_WAIT_L(0); PG8_BAR; PG8_MMA(1, 0, At, B0); PG8_MMA(1, 1, At, B1); PG8_BAR; PG8_SCHED;
            PG8_LDB(B0, 1, 0); PG8_LDB(B1, 1, 1); PG8_SCHED; PG8_LDA(At, 1, 0); PG8_STAGE(PG8_SA(0, 1), a2 + hstep, voffA);
            PG8_WAIT_V(8); PG8_WAIT_L(0); PG8_BAR; PG8_MMA(0, 0, At, B0); PG8_MMA(0, 1, At, B1); PG8_BAR; PG8_SCHED;
            PG8_LDA(At, 1, 1); PG8_STAGE(PG8_SB(1, 0), b3, voffB); PG8_STAGE(PG8_SB(1, 1), b3 + hstep, voffB); PG8_STAGE(PG8_SA(1, 0), a3, voffA);
            PG8_WAIT_V(8); PG8_WAIT_L(0); PG8_BAR; PG8_MMA(1, 0, At, B0); PG8_MMA(1, 1, At, B1); PG8_BAR; PG8_SCHED;
            } else {
            PG8_LDB(B0, 0, 0); PG8_SCHED; PG8_LDA(At, 0, 0); PG8_STAGE(PG8_SA(1, 1), a1 + hstep, voffA);
            PG8_WAIT_L(8); PG8_BAR; PG8_WAIT_L(0); PG8_MMA(0, 0, At, B0); PG8_BAR; PG8_SCHED;
            PG8_LDB(B1, 0, 1); PG8_STAGE(PG8_SB(0, 0), b2, voffB);
            PG8_BAR; PG8_WAIT_L(0); PG8_MMA(0, 1, At, B1); PG8_BAR;
            PG8_LDA(At, 0, 1); PG8_STAGE(PG8_SA(0, 0), a2, voffA);
            PG8_BAR; PG8_WAIT_L(0); PG8_MMA(1, 0, At, B0); PG8_BAR; PG8_SCHED;
            PG8_STAGE(PG8_SB(0, 1), b2 + hstep, voffB);
            PG8_WAIT_V(6); PG8_BAR; PG8_MMA(1, 1, At, B1); PG8_BAR;
            PG8_LDB(B0, 1, 0); PG8_SCHED; PG8_LDA(At, 1, 0); PG8_STAGE(PG8_SA(0, 1), a2 + hstep, voffA);
            PG8_WAIT_L(8); PG8_BAR; PG8_WAIT_L(0); PG8_MMA(0, 0, At, B0); PG8_BAR; PG8_SCHED;
            PG8_LDB(B1, 1, 1); PG8_STAGE(PG8_SB(1, 0), b3, voffB);
            PG8_BAR; PG8_WAIT_L(0); PG8_MMA(0, 1, At, B1); PG8_BAR;
            PG8_LDA(At, 1, 1); PG8_STAGE(PG8_SA(1, 0), a3, voffA);
            PG8_BAR; PG8_WAIT_L(0); PG8_MMA(1, 0, At, B0); PG8_BAR; PG8_SCHED;
            PG8_STAGE(PG8_SB(1, 1), b3 + hstep, voffB);
            PG8_WAIT_V(6); PG8_BAR; PG8_MMA(1, 1, At, B1); PG8_BAR;
            }
        }
        if constexpr (ALIGN_EPI) { if (wr == 0) PG8_BAR; }
        if constexpr (!Epi::AFTER_DRAIN) { E(acc, cur, wr, wc, fr, fq); S.done(cur); }
        if (!has_next) break;
#pragma unroll
        for (int a = 0; a < 2; ++a)
#pragma unroll
            for (int b = 0; b < 2; ++b)
#pragma unroll
                for (int m = 0; m < 4; ++m)
#pragma unroll
                    for (int n = 0; n < 2; ++n) acc[a][b][m][n] = (f32x4){0.f, 0.f, 0.f, 0.f};
        cur = nxt; cA = nA; cB = nB; ++ui;
        if constexpr (ALIGN_EPI) { if (wr == 1) PG8_BAR; }
    }
    PG8_WAIT_V(0);
    if constexpr (!ALIGN_EPI) { if (wr == 0) PG8_BAR; }
    PG8_BAR;
    if constexpr (Epi::AFTER_DRAIN) { E.fused(acc, cur, wr, wc, fr, fq, lds, wid, lane); S.done(cur); }
#undef PG8_SA
#undef PG8_SB
#undef PG8_STAGE
#undef PG8_LDA
#undef PG8_LDB
#undef PG8_MMA
#undef PG8_WAIT_V
#undef PG8_WAIT_L
#undef PG8_BAR
#undef PG8_SCHED
}
}
constexpr int NWAVES = 8, NTHR = 512;
constexpr int D = 2048, BATCH = 4, SEQ = 2048, DEC_B = 128, DEC_T = 4, PAST = 16384;
constexpr int MP = BATCH * SEQ;
constexpr int MS = DEC_B * DEC_T;
constexpr int M = MP + MS;
constexpr int HALFW = 1024, RH = 4, DK = 256, LRU_W = 1024, LRU_H = 8, LRU_BLK = 128, INW = 6144;
constexpr int SG = 128, SP = 64, FF = 5632, NCH = 16, CH = 128;
constexpr float EPS = 1e-6f;
constexpr int NPOS = SEQ + DEC_T;

enum { I_XP = 0, I_XS, I_SRET, I_SLRU, I_SCONV, I_SSRE, I_SSIM, I_NME, I_WIN, I_CW, I_CB, I_WA, I_BA, I_WX, I_BX, I_LAM, I_WOUT, I_NMO, I_ARE, I_AIM,
       I_BRE, I_BIM, I_CRE, I_CIM, I_SD, I_LDT, I_WGLU, I_BGLU, I_NF, I_WGU, I_WDN, I_NFIN, N_IN };

constexpr size_t O_YP = 0, O_YS = O_YP + (size_t)MP * D, O_RETP = O_YS + (size_t)MS * D, O_RETS = O_RETP + (size_t)2 * BATCH * RH * DK * DK,
                 O_LRUP = O_RETS + (size_t)2 * DEC_B * RH * DK * DK, O_LRUS = O_LRUP + (size_t)2 * BATCH * LRU_W, O_CONVP = O_LRUS + (size_t)2 * DEC_B * LRU_W,
                 O_CONVS = O_CONVP + (size_t)2 * BATCH * 3 * LRU_W, O_SREP = O_CONVS + (size_t)2 * DEC_B * 3 * LRU_W, O_SRES = O_SREP + (size_t)2 * BATCH * SG * SP,
                 O_SIMP = O_SRES + (size_t)2 * DEC_B * SG * SP, O_SIMS = O_SIMP + (size_t)2 * BATCH * SG * SP, O_END = O_SIMS + (size_t)2 * DEC_B * SG * SP;

constexpr size_t al256(size_t x) { return (x + 255) & ~(size_t)255; }
constexpr size_t WS_CTL = 0, CTL_BYTES = 1u << 20, CTL_ZERO_BYTES = 32768;
constexpr size_t SZ_WIN = (size_t)INW * D * 2, SZ_WOUT = (size_t)D * D * 2, SZ_WGLU = (size_t)2 * D * D * 2, SZ_WGU = (size_t)2 * FF * D * 2, SZ_WDN = (size_t)D * FF * 2;
constexpr size_t WS_WIN = CTL_BYTES, WS_WOUT = WS_WIN + 2 * SZ_WIN, WS_WGLU = WS_WOUT + 2 * SZ_WOUT, WS_WGU = WS_WGLU + 2 * SZ_WGLU, WS_WDN = WS_WGU + 4 * SZ_WGU;
constexpr size_t WS_X = WS_WDN + 4 * SZ_WDN;
constexpr size_t WS_XN = WS_X + (size_t)M * D * 4;
constexpr size_t WS_PROJ = WS_XN + (size_t)M * D * 2;
constexpr size_t WS_H = WS_PROJ + (size_t)M * INW * 2;
constexpr size_t WS_CAT = WS_H + (size_t)M * FF * 2;
constexpr size_t WS_UT = WS_CAT + (size_t)M * D * 2;
constexpr size_t WS_ROPE = WS_UT + (size_t)256 * 65536 * 4;
constexpr size_t WS_LRUW = al256(WS_ROPE + (size_t)2 * NPOS * 128 * 4);
constexpr size_t WS_LRUC = WS_LRUW + (size_t)2 * 8 * 256 * 128 * 2;
constexpr size_t WS_LSA = WS_LRUC + (size_t)2 * 1024 * 4;
constexpr size_t WS_LSB = WS_LSA + (size_t)4 * 16 * 1024 * 4;
constexpr size_t WS_LCIN = WS_LSB + (size_t)4 * 16 * 1024 * 4;
constexpr size_t WS_S5BB = WS_LCIN + (size_t)4 * 16 * 1024 * 4;
constexpr size_t WS_S5CM = WS_S5BB + (size_t)2 * 128 * 128 * 16 * 2;
constexpr size_t WS_S5AB = WS_S5CM + (size_t)2 * 128 * 16 * 128 * 2;
constexpr size_t WS_S5LOC = WS_S5AB + (size_t)2 * 8192 * 4 * 4;
constexpr size_t WS_SLAB = WS_S5LOC + (size_t)4 * 16 * 8192 * 2 * 4;
constexpr size_t WS_S5PW = WS_SLAB + (size_t)8 * 512 * 4096 * 4;
constexpr size_t WS_END = WS_S5PW + (size_t)2 * 128 * 8 * 8 * 64 * 8;
constexpr int S_DN = 11, S_OUT = 8, S_GLU = 8;
static_assert(WS_END < (size_t)1000 * 1000 * 1000, "workspace map must stay below the guaranteed d_ws size");
constexpr int CW_BAR = 4096;
static_assert((CW_BAR + 3456) * 4 <= (int)CTL_ZERO_BYTES, "barrier words inside the zeroed region");

constexpr int LDS_BYTES = 147456;
constexpr int MISC_OFF = 146944;
constexpr int PH_LDS = 146944;

constexpr int NPHASE = 1 + 9 * 4;
#ifndef MK_ONE_LAUNCH
#define MK_ONE_LAUNCH 0
#endif
#define GAS __attribute__((address_space(1)))
#define LAS __attribute__((address_space(3)))
typedef unsigned short __attribute__((may_alias)) bf16;
typedef unsigned v4u __attribute__((ext_vector_type(4), may_alias));
typedef unsigned v2u __attribute__((ext_vector_type(2), may_alias));
typedef float f32x4 __attribute__((ext_vector_type(4), may_alias));
typedef float f32x2 __attribute__((ext_vector_type(2), may_alias));
typedef short bf16x8 __attribute__((ext_vector_type(8), may_alias));
typedef short bf16x4 __attribute__((ext_vector_type(4), may_alias));
typedef unsigned __attribute__((may_alias)) u32a;
typedef float __attribute__((may_alias)) f32a;
#define LDS_WAIT() asm volatile("s_waitcnt lgkmcnt(0)" ::: "memory")
#define VM_WAIT() asm volatile("s_waitcnt vmcnt(0)" ::: "memory")
typedef __bf16 bf16v2 __attribute__((ext_vector_type(2)));
typedef float f32v2c __attribute__((ext_vector_type(2)));
__device__ __forceinline__ unsigned pk2(float lo, float hi) { const f32v2c v = {lo, hi}; return __builtin_bit_cast(unsigned, __builtin_convertvector(v, bf16v2)); }
__device__ __forceinline__ unsigned f2bf(float f) { return pk2(f, f) & 0xffffu; }
__device__ __forceinline__ float bflo(unsigned w) { return __builtin_bit_cast(float, w << 16); }
__device__ __forceinline__ float bfhi(unsigned w) { return __builtin_bit_cast(float, w & 0xffff0000u); }
__device__ __forceinline__ float bf2f(bf16 h) { return __builtin_bit_cast(float, (unsigned)h << 16); }
__device__ __forceinline__ float wave_sum(float v) {
#pragma unroll
    for (int o = 1; o < 64; o <<= 1) v += __shfl_xor(v, o);
    return v;
}
__device__ __forceinline__ float sigmoidf_(float x) { return __builtin_amdgcn_rcpf(1.0f + __builtin_amdgcn_exp2f(-1.44269504f * x)); }
__device__ __forceinline__ float siluf_(float x) { return x * sigmoidf_(x); }
__device__ __forceinline__ float geluf_(float x) { const float u = 0.7978845608f * (x + 0.044715f * x * x * x); return x * sigmoidf_(2.0f * u); }
#define MFMA32(a, b, c) __builtin_amdgcn_mfma_f32_16x16x32_bf16((a), (b), (c), 0, 0, 0)
#define MFMA16(a, b, c) __builtin_amdgcn_mfma_f32_16x16x16bf16_1k((a), (b), (c), 0, 0, 0)
#if defined(__HIP_DEVICE_COMPILE__)
#define ASSUME_GLOBAL(p) __builtin_assume(!__builtin_amdgcn_is_shared((const __attribute__((address_space(0))) void*)(p)) && !__builtin_amdgcn_is_private((const __attribute__((address_space(0))) void*)(p)))
#else
#define ASSUME_GLOBAL(p) ((void)0)
#endif
#define XB_TMO      128
#define XB_XCNT(j)  (256  + 64 * (j))
#define XB_XSUB(j)  (1280 + 64 * (j))
#define XB_XGEN(j)  (2304 + 64 * (j))
#define XB_TOP      3328
#define XB_TOPGEN   3392
#define XCD_BAR_WORDS 3456
#define XB_SPIN_CAP (1u << 18)

__device__ __forceinline__ unsigned xb_ld(unsigned* p)              { return __hip_atomic_load(p, __ATOMIC_RELAXED, __HIP_MEMORY_SCOPE_AGENT); }
__device__ __forceinline__ unsigned xb_add(unsigned* p, unsigned v) { return __hip_atomic_fetch_add(p, v, __ATOMIC_RELAXED, __HIP_MEMORY_SCOPE_AGENT); }
__device__ __forceinline__ unsigned xb_xcc_id() { return (unsigned)__builtin_amdgcn_s_getreg((3 << 11) | 20) & 0xFu; }
#define XB_SPIN(cond, bar) do { unsigned _sp = 0; while (cond) { __builtin_amdgcn_s_sleep(1); \
    if ((++_sp & 255u) == 0u) { if (xb_ld(&(bar)[XB_TMO])) break; if (_sp > XB_SPIN_CAP) { atomicAdd(&(bar)[XB_TMO], 1u); break; } } } } while (0)

struct XcdBarrier {
    unsigned* bar; unsigned x;
    volatile LAS unsigned* st;
};

__device__ __forceinline__ XcdBarrier xcd_barrier_post(unsigned* bar, volatile LAS unsigned* st) {
    XcdBarrier b; b.bar = bar; b.x = xb_xcc_id(); b.st = st;
    if (threadIdx.x == 0) (void)xb_add(&bar[XB_XCNT(b.x)], 1u);
    return b;
}
__device__ __forceinline__ void xcd_barrier_complete(unsigned* bar, unsigned x, unsigned& nloc, unsigned& nx) {
    const unsigned G = gridDim.x * gridDim.y * gridDim.z;
    unsigned sum, cnt, mine, sp = 0u;
    for (;;) {
        sum = 0u; cnt = 0u; mine = 0u;
#pragma unroll
        for (unsigned j = 0; j < 16; ++j) { const unsigned c = xb_ld(&bar[XB_XCNT(j)]); sum += c; cnt += (c > 0u) ? 1u : 0u; mine = (j == x) ? c : mine; }
        if (sum == G) break;
        __builtin_amdgcn_s_sleep(1);
        if ((++sp & 255u) == 0u) { if (xb_ld(&bar[XB_TMO])) break; if (sp > XB_SPIN_CAP) { atomicAdd(&bar[XB_TMO], 1u); break; } }
    }
    nloc = mine > 0u ? mine : 1u; nx = cnt > 0u ? cnt : 1u;
}

__device__ __forceinline__ void xcd_barrier(const XcdBarrier& b, int tid_) {
    asm volatile("s_waitcnt vmcnt(0)" ::: "memory");
    __syncthreads();
    if (tid_ == 0) {
        unsigned* bar = b.bar;
        __builtin_amdgcn_s_waitcnt(0);
        unsigned nloc = b.st[0], nx = b.st[1];
        if (nloc == 0u) { xcd_barrier_complete(bar, b.x, nloc, nx); b.st[0] = nloc; b.st[1] = nx; }
        const unsigned old = xb_add(&bar[XB_XSUB(b.x)], 1u);
        const unsigned gen = old / nloc;
        if (old + 1u == (gen + 1u) * nloc) {
            __builtin_amdgcn_fence(__ATOMIC_RELEASE, "agent");
            asm volatile("s_waitcnt vmcnt(0)" ::: "memory");
            const unsigned og = xb_add(&bar[XB_TOP], 1u);
            const unsigned tg = og / nx;
            if (og + 1u == (tg + 1u) * nx) xb_add(&bar[XB_TOPGEN], 1u);
            else XB_SPIN(xb_ld(&bar[XB_TOPGEN]) == tg, bar);
            __builtin_amdgcn_fence(__ATOMIC_ACQUIRE, "agent");
            xb_add(&bar[XB_XGEN(b.x)], 1u);
            asm volatile("s_waitcnt vmcnt(0)" ::: "memory");
        } else {
            XB_SPIN(xb_ld(&bar[XB_XGEN(b.x)]) == gen, bar);
            __builtin_amdgcn_fence(__ATOMIC_ACQUIRE, "agent");
            asm volatile("s_waitcnt vmcnt(0)" ::: "memory");
        }
    }
    __syncthreads();
}
struct Frame {
    LAS unsigned char* lds;
    int tid, lane, wave, G, bid;
    GAS float* out; GAS unsigned char* ws;
    __device__ __forceinline__ const GAS float* inp(int i) const {
        const __attribute__((address_space(4))) char* ka = (const __attribute__((address_space(4))) char*)__builtin_amdgcn_kernarg_segment_ptr();
        return (const GAS float*)*(volatile const __attribute__((address_space(4))) unsigned long long*)(ka + 8 * i);
    }
};

__device__ __forceinline__ void tr_item(const GAS float* W, int K, int N, GAS bf16* WT, int k0, int n0, int dst_row0, const GAS float* gain, LAS float* scr, int lane) {
    const int kr = lane >> 3, c4 = lane & 7;
    f32x4 v[8];
#pragma unroll
    for (int i = 0; i < 8; ++i) v[i] = __builtin_nontemporal_load((const GAS f32x4*)(W + (size_t)(k0 + 8 * i + kr) * N + n0 + 4 * c4));
    if (gain) {
#pragma unroll
        for (int i = 0; i < 8; ++i) v[i] = v[i] * gain[k0 + 8 * i + kr]; }
#pragma unroll
    for (int i = 0; i < 8; ++i) { LAS float* d = scr + (8 * i + kr) * 33 + 4 * c4; d[0] = v[i].x; d[1] = v[i].y; d[2] = v[i].z; d[3] = v[i].w; }
    LDS_WAIT(); asm volatile("" ::: "memory");
    const int c = lane & 7;
#pragma unroll
    for (int j = 0; j < 4; ++j) { const int n = (lane >> 3) + 8 * j; const LAS float* s = scr + (8 * c) * 33 + n;
        v4u o; o.x = pk2(s[0 * 33], s[1 * 33]); o.y = pk2(s[2 * 33], s[3 * 33]); o.z = pk2(s[4 * 33], s[5 * 33]); o.w = pk2(s[6 * 33], s[7 * 33]);
        *(GAS v4u*)(WT + (size_t)(dst_row0 + n) * K + k0 + 8 * c) = o; }
    LDS_WAIT(); asm volatile("" ::: "memory");
}
__device__ __forceinline__ int pair_row(int n, int Fh) { const int half = n / Fh, j = n - half * Fh; return (j >> 7) * 256 + half * 128 + (j & 127); }
__device__ __forceinline__ void sincos_pi(double r, double& s, double& c) {
    const double x2 = r * r; double ts = 1.0, tc = 1.0, ss = 1.0, cc = 1.0;
#pragma unroll
    for (int k = 1; k <= 14; ++k) { tc *= -x2 / (double)((2 * k - 1) * (2 * k)); cc += tc; ts *= -x2 / (double)((2 * k) * (2 * k + 1)); ss += ts; }
    s = r * ss; c = cc;
}
__device__ __forceinline__ void sincos_big(double ang, double& s, double& c) {
    const double TWO_PI = 6.283185307179586476925286766559; const double k = rint(ang / TWO_PI); sincos_pi(ang - k * TWO_PI, s, c);
}
template <int FIN>
__device__ __forceinline__ void rms_row(const GAS float* xrow, GAS float* xcopy, GAS bf16* orow, GAS float* frow, const GAS float* gain, int lane, const GAS float* slab0, size_t spitch, int ns, const GAS float* gbias) {
    const GAS f32x4* xr = (const GAS f32x4*)xrow + lane;
    f32x4 v[8]; float s = 0.f;
#pragma unroll
    for (int j = 0; j < 8; ++j) v[j] = xr[64 * j];
    if (FIN == 1) {
#pragma unroll 1
        for (int sl = 0; sl < ns; ++sl) { const GAS f32x4* pr = (const GAS f32x4*)(slab0 + (size_t)sl * spitch) + lane;
#pragma unroll
            for (int j = 0; j < 8; ++j) v[j] += pr[64 * j]; } }
    if (FIN == 2) {
        f32x4 z1[8], z2[8];
#pragma unroll
        for (int j = 0; j < 8; ++j) { const int c = 4 * lane + 256 * j; z1[j] = *(const GAS f32x4*)(gbias + c); z2[j] = *(const GAS f32x4*)(gbias + D + c); }
#pragma unroll 1
        for (int sl = 0; sl < ns; ++sl) { const GAS float* pr = slab0 + (size_t)sl * spitch;
#pragma unroll
            for (int j = 0; j < 8; ++j) { const int c = 4 * lane + 256 * j, gc = (c >> 7) * 256 + (c & 127); z1[j] += *(const GAS f32x4*)(pr + gc); z2[j] += *(const GAS f32x4*)(pr + gc + 128); } }
#pragma unroll
        for (int j = 0; j < 8; ++j) { v[j].x += z1[j].x * sigmoidf_(z2[j].x); v[j].y += z1[j].y * sigmoidf_(z2[j].y); v[j].z += z1[j].z * sigmoidf_(z2[j].z); v[j].w += z1[j].w * sigmoidf_(z2[j].w); } }
#pragma unroll
    for (int j = 0; j < 8; ++j) s += (v[j].x * v[j].x + v[j].y * v[j].y) + (v[j].z * v[j].z + v[j].w * v[j].w);
    const float rstd = 1.0f / sqrtf(wave_sum(s) * (1.f / D) + EPS);
    if (xcopy) { GAS f32x4* xc = (GAS f32x4*)xcopy + lane;
#pragma unroll
        for (int j = 0; j < 8; ++j) xc[64 * j] = v[j]; }
#pragma unroll
    for (int j = 0; j < 8; ++j) { f32x4 g = (f32x4){1.f, 1.f, 1.f, 1.f}; if (gain) g = ((const GAS f32x4*)gain)[lane + 64 * j]; v[j] = v[j] * rstd * g; }
    if (orow) { GAS v2u* o8 = (GAS v2u*)orow + lane;
#pragma unroll
        for (int j = 0; j < 8; ++j) { v2u w; w.x = pk2(v[j].x, v[j].y); w.y = pk2(v[j].z, v[j].w); o8[64 * j] = w; } }
    else { GAS f32x4* o = (GAS f32x4*)frow + lane;
#pragma unroll
        for (int j = 0; j < 8; ++j) o[64 * j] = v[j]; }
}
__device__ __forceinline__ void rms_phase(const Frame& F, int mode, const GAS float* gain, int fin, int ns, const GAS float* gbias) {
    const int gw = F.bid * NWAVES + F.wave, NGW = F.G * NWAVES;
    GAS float* X = (GAS float*)(F.ws + WS_X); GAS bf16* XN = (GAS bf16*)(F.ws + WS_XN); const GAS float* SLAB = (const GAS float*)(F.ws + WS_SLAB);
    {
        LAS float* red = (LAS float*)F.lds;
        const int sub = F.wave & 3, rsel = F.wave >> 2;
#pragma unroll 1
        for (int r0 = 2 * F.bid; r0 < MS; r0 += 2 * F.G) {
            const int m = MP + r0 + rsel; GAS float* xr = X + (size_t)m * D + 512 * sub;
            f32x4 v[2]; v[0] = ((const GAS f32x4*)xr)[F.lane]; v[1] = ((const GAS f32x4*)xr)[F.lane + 64];
            if (fin == 1) { const GAS float* sl = SLAB + (size_t)(r0 + rsel) * D + 512 * sub;
                for (int s = 0; s < ns; ++s) { v[0] += ((const GAS f32x4*)(sl + (size_t)s * MS * D))[F.lane]; v[1] += ((const GAS f32x4*)(sl + (size_t)s * MS * D))[F.lane + 64]; } }
            else { f32x4 z1[2], z2[2];
#pragma unroll
                for (int j = 0; j < 2; ++j) { const int c = 512 * sub + 4 * F.lane + 256 * j; z1[j] = *(const GAS f32x4*)(gbias + c); z2[j] = *(const GAS f32x4*)(gbias + D + c); }
                const GAS float* sl = SLAB + (size_t)(r0 + rsel) * 2 * D;
                for (int s = 0; s < ns; ++s) {
#pragma unroll
                    for (int j = 0; j < 2; ++j) { const int c = 512 * sub + 4 * F.lane + 256 * j, gc = (c >> 7) * 256 + (c & 127); z1[j] += *(const GAS f32x4*)(sl + (size_t)s * MS * 2 * D + gc); z2[j] += *(const GAS f32x4*)(sl + (size_t)s * MS * 2 * D + gc + 128); } }
#pragma unroll
                for (int j = 0; j < 2; ++j) { v[j].x += z1[j].x * sigmoidf_(z2[j].x); v[j].y += z1[j].y * sigmoidf_(z2[j].y); v[j].z += z1[j].z * sigmoidf_(z2[j].z); v[j].w += z1[j].w * sigmoidf_(z2[j].w); } }
            float ss = 0.f;
#pragma unroll
            for (int j = 0; j < 2; ++j) ss += (v[j].x * v[j].x + v[j].y * v[j].y) + (v[j].z * v[j].z + v[j].w * v[j].w);
            ss = wave_sum(ss);
            __syncthreads(); if (F.lane == 0) red[F.wave] = ss; __syncthreads();
            const float rstd = 1.0f / sqrtf(((red[4 * rsel] + red[4 * rsel + 1]) + (red[4 * rsel + 2] + red[4 * rsel + 3])) * (1.f / D) + EPS);
            ((GAS f32x4*)xr)[F.lane] = v[0]; ((GAS f32x4*)xr)[F.lane + 64] = v[1];
#pragma unroll
            for (int j = 0; j < 2; ++j) { f32x4 g = (f32x4){1.f, 1.f, 1.f, 1.f}; if (mode != 0) g = *(const GAS f32x4*)(gain + 512 * sub + 4 * (F.lane + 64 * j)); const f32x4 o = v[j] * rstd * g;
                if (mode == 2) *(GAS f32x4*)(F.out + O_YP + (size_t)m * D + 512 * sub + 4 * (F.lane + 64 * j)) = o;
                else { v2u w; w.x = pk2(o.x, o.y); w.y = pk2(o.z, o.w); *(GAS v2u*)(XN + (size_t)m * D + 512 * sub + 4 * (F.lane + 64 * j)) = w; } }
        }
    }
#ifndef REP_RMSP
#define REP_RMSP 0
#endif
    for (int rep = 0; rep <= REP_RMSP; ++rep)
    for (int m = gw; m < MP; m += NGW) {
        if (mode == 2) rms_row<0>(X + (size_t)m * D, nullptr, nullptr, F.out + O_YP + (size_t)m * D, gain, F.lane, nullptr, 0, 0, nullptr);
        else rms_row<0>(X + (size_t)m * D, nullptr, XN + (size_t)m * D, nullptr, mode == 1 ? gain : nullptr, F.lane, nullptr, 0, 0, nullptr);
    }
}

constexpr int IT_IN = 32 * (INW / 32), IT_OUT = 32 * (D / 32), IT_GLU = 32 * (2 * D / 32), IT_GU = 32 * (2 * FF / 32), IT_DN = (FF / 64) * (D / 32);
constexpr int CV_E0 = IT_IN, CV_E1 = CV_E0 + IT_OUT, CV_E2 = CV_E1 + IT_GU, CV_E3 = CV_E2 + IT_DN, CV_E4 = CV_E3 + IT_GLU, CV_E5 = CV_E4 + IT_GU, CV_E6 = CV_E5 + IT_DN,
              CV_E7 = CV_E6 + IT_IN, CV_E8 = CV_E7 + IT_OUT, CV_E9 = CV_E8 + IT_GU, CV_E10 = CV_E9 + IT_DN, CV_E11 = CV_E10 + IT_GLU, CV_E12 = CV_E11 + IT_GU, CV_E13 = CV_E12 + IT_DN;
constexpr int CV_T2E = CV_E3 + 2048, CV_T3E = CV_T2E + 4480, CV_T4E = CV_T3E + 2560;
constexpr int CV_T5E = CV_E6 + 4480;
constexpr int CV_T7E = CV_E10 + 2048, CV_T8E = CV_T7E + 4480, CV_T9E = CV_T8E + 2560;
static_assert(CV_T4E <= CV_E5 && CV_T9E <= CV_E12, "tail ranges stay inside the matrices needed later");
__device__ __forceinline__ void conv_item(const Frame& F, int it, LAS float* scr) {
    int r = it, seg_type, lay;
    if (r < CV_E0) { seg_type = 0; lay = 0; }
    else if (r < CV_E1) { r -= CV_E0; seg_type = 1; lay = 0; }
    else if (r < CV_E2) { r -= CV_E1; seg_type = 3; lay = 0; }
    else if (r < CV_E3) { r -= CV_E2; seg_type = 4; lay = 0; }
    else if (r < CV_E4) { r -= CV_E3; seg_type = 2; lay = 0; }
    else if (r < CV_E5) { r -= CV_E4; seg_type = 3; lay = 1; }
    else if (r < CV_E6) { r -= CV_E5; seg_type = 4; lay = 1; }
    else if (r < CV_E7) { r -= CV_E6; seg_type = 0; lay = 1; }
    else if (r < CV_E8) { r -= CV_E7; seg_type = 1; lay = 1; }
    else if (r < CV_E9) { r -= CV_E8; seg_type = 3; lay = 2; }
    else if (r < CV_E10) { r -= CV_E9; seg_type = 4; lay = 2; }
    else if (r < CV_E11) { r -= CV_E10; seg_type = 2; lay = 1; }
    else if (r < CV_E12) { r -= CV_E11; seg_type = 3; lay = 3; }
    else { r -= CV_E12; seg_type = 4; lay = 3; }
    const GAS float* W; GAS bf16* WT; const GAS float* gain = nullptr; int K = D, N, dst; int nblk;
    if (seg_type == 0) { N = INW; W = F.inp(I_WIN) + (size_t)lay * D * INW; WT = (GAS bf16*)(F.ws + WS_WIN + lay * SZ_WIN); gain = F.inp(I_NME) + lay * D; }
    else if (seg_type == 1) { N = D; W = F.inp(I_WOUT) + (size_t)lay * D * D; WT = (GAS bf16*)(F.ws + WS_WOUT + lay * SZ_WOUT); }
    else if (seg_type == 2) { N = 2 * D; W = F.inp(I_WGLU) + (size_t)lay * D * 2 * D; WT = (GAS bf16*)(F.ws + WS_WGLU + lay * SZ_WGLU); }
    else if (seg_type == 3) { N = 2 * FF; W = F.inp(I_WGU) + (size_t)lay * D * 2 * FF; WT = (GAS bf16*)(F.ws + WS_WGU + lay * SZ_WGU); gain = F.inp(I_NF) + lay * D; }
    else { N = D; K = FF; W = F.inp(I_WDN) + (size_t)lay * FF * D; WT = (GAS bf16*)(F.ws + WS_WDN + lay * SZ_WDN); }
    nblk = N / 32; const int kb = r / nblk, nb = r - kb * nblk;
    dst = seg_type == 2 ? pair_row(32 * nb, D) : (seg_type == 3 ? pair_row(32 * nb, FF) : 32 * nb);
    tr_item(W, K, N, WT, 64 * kb, 32 * nb, dst, gain, scr, F.lane);
}
__device__ __forceinline__ void conv_in_tail(const Frame& F, int lo, int hi, int nbusy) {
    if (F.bid < nbusy) return;
    LAS float* scr = (LAS float*)(F.lds + F.wave * 16384);
    const int w = (F.bid - nbusy) * NWAVES + F.wave, nw = (F.G - nbusy) * NWAVES;
    for (int it = lo + w; it < hi; it += nw) conv_item(F, it, scr);
}

__device__ __forceinline__ void p0_prologue(const Frame& F) {
    const int gw = F.bid * NWAVES + F.wave, NGW = F.G * NWAVES;
    { LAS float* scr = (LAS float*)(F.lds + F.wave * 16384);
      constexpr int N1 = CV_E0, N2 = CV_E6 - CV_T4E, N3 = CV_E13 - CV_T9E;
      for (int i = gw; i < N1 + N2 + N3; i += NGW) { const int it = i < N1 ? i : (i < N1 + N2 ? CV_T4E + (i - N1) : CV_T9E + (i - N1 - N2)); conv_item(F, it, scr); } }
    { GAS float* X = (GAS float*)(F.ws + WS_X); GAS bf16* XN = (GAS bf16*)(F.ws + WS_XN);
      for (int m = gw; m < M; m += NGW) { const GAS float* src = m < MP ? F.inp(I_XP) + (size_t)m * D : F.inp(I_XS) + (size_t)(m - MP) * D;
          rms_row<0>(src, X + (size_t)m * D, XN + (size_t)m * D, nullptr, nullptr, F.lane, nullptr, 0, 0, nullptr); } }
    const int gt = F.bid * NTHR + F.tid, NGT = F.G * NTHR;
    { GAS float* COS = (GAS float*)(F.ws + WS_ROPE); GAS float* SIN = COS + NPOS * 128;
      for (int i = gt; i < NPOS * 128; i += NGT) { const int pi = i >> 7, f = i & 127; const double pos = pi < SEQ ? (double)pi : (double)(PAST + pi - SEQ);
          const double inv = exp(-9.2103403719761827361 * (double)f / 127.0); double s, c; sincos_big(pos * inv, s, c); COS[i] = (float)c; SIN[i] = (float)s; } }
    { GAS bf16* LW = (GAS bf16*)(F.ws + WS_LRUW);
      for (int i = gt; i < 2 * 8 * 256 * 128; i += NGT) { const int k = i & 127, j2 = (i >> 7) & 255, en = i >> 15;
          const GAS float* src = (j2 < 128 ? F.inp(I_WA) : F.inp(I_WX)) + ((size_t)en * 128 + k) * 128 + (j2 & 127); LW[i] = (bf16)f2bf(*src); }
      GAS float* LC = (GAS float*)(F.ws + WS_LRUC);
      for (int i = gt; i < 2 * 1024; i += NGT) LC[i] = 8.0f * log1pf(expf(-F.inp(I_LAM)[i])); }
    { GAS bf16* BB = (GAS bf16*)(F.ws + WS_S5BB); GAS bf16* CM = (GAS bf16*)(F.ws + WS_S5CM); GAS float* AB = (GAS float*)(F.ws + WS_S5AB);
      for (int i = gt; i < 2 * SG * SP; i += NGT) { const int p = i & 63, g = (i >> 6) & 127, o = i >> 13;
          const double dt = exp((double)F.inp(I_LDT)[o * SG + g]), are = (double)F.inp(I_ARE)[i], aim = (double)F.inp(I_AIM)[i];
          double s, c; sincos_big(aim * dt, s, c); const double mag = exp(are * dt), abr = mag * c, abi = mag * s;
          double s2, c2; sincos_big(128.0 * aim * dt, s2, c2); const double mag2 = exp(128.0 * are * dt);
          const double den = are * are + aim * aim, nr = abr - 1.0, ni = abi, fr = (nr * are + ni * aim) / den, fi = (ni * are - nr * aim) / den;
          AB[(size_t)i * 4 + 0] = (float)abr; AB[(size_t)i * 4 + 1] = (float)abi; AB[(size_t)i * 4 + 2] = (float)(mag2 * c2); AB[(size_t)i * 4 + 3] = (float)(mag2 * s2);
          const GAS float* bre = F.inp(I_BRE) + (size_t)i * 16; const GAS float* bim = F.inp(I_BIM) + (size_t)i * 16;
          GAS bf16* bbr = BB + ((size_t)(o * SG + g) * 128 + 2 * p) * 16; GAS bf16* bbi = BB + ((size_t)(o * SG + g) * 128 + 2 * p + 1) * 16;
          for (int k = 0; k < 16; ++k) { const double br = bre[k], bi = bim[k]; bbr[k] = (bf16)f2bf((float)(fr * br - fi * bi)); bbi[k] = (bf16)f2bf((float)(fr * bi + fi * br)); }
          const GAS float* cre = F.inp(I_CRE) + (size_t)(o * SG + g) * 16 * 64; const GAS float* cim = F.inp(I_CIM) + (size_t)(o * SG + g) * 16 * 64;
          GAS bf16* cm = CM + (size_t)(o * SG + g) * 16 * 128;
          for (int k = 0; k < 16; ++k) { cm[k * 128 + 2 * p] = (bf16)f2bf(cre[k * 64 + p]); cm[k * 128 + 2 * p + 1] = (bf16)f2bf(-cim[k * 64 + p]); } }
      { GAS v2u* PW = (GAS v2u*)(F.ws + WS_S5PW);
        for (int it = gt; it < 2 * SG * SP * 8; it += NGT) { const int i = it >> 3, part = it & 7, p = i & 63, og = i >> 6;
            const double dt = exp((double)F.inp(I_LDT)[og]), are = (double)F.inp(I_ARE)[i], aim = (double)F.inp(I_AIM)[i];
            double s, c; sincos_big(aim * dt, s, c); const double mag = exp(are * dt), ar = mag * c, ai = mag * s;
            const double a2r = ar * ar - ai * ai, a2i = 2.0 * ar * ai, a3r = a2r * ar - a2i * ai, a3i = a2r * ai + a2i * ar, a4r = a2r * a2r - a2i * a2i, a4i = 2.0 * a2r * a2i;
            const double a8r = a4r * a4r - a4i * a4i, a8i = 2.0 * a4r * a4i, a16r = a8r * a8r - a8i * a8i, a16i = 2.0 * a8r * a8i;
            double wr = 1.0, wi = 0.0;
            for (int q = 0; q < part; ++q) { const double nr = wr * a16r - wi * a16i, ni = wr * a16i + wi * a16r; wr = nr; wi = ni; }
            for (int jj = 0; jj < 4; ++jj) { const int j = 4 * part + jj, sq = 31 - j, sub = sq >> 2, fq = sq & 3;
                const double p1r = wr * ar - wi * ai, p1i = wr * ai + wi * ar, p2r = wr * a2r - wi * a2i, p2i = wr * a2i + wi * a2r, p3r = wr * a3r - wi * a3i, p3i = wr * a3i + wi * a3r;
                const size_t idx = ((size_t)(og * 8 + sub) * 8 + (p >> 3)) * 64 + 16 * fq + 2 * (p & 7);
                v2u re, im; re.x = pk2((float)p3r, (float)p2r); re.y = pk2((float)p1r, (float)wr); im.x = pk2((float)p3i, (float)p2i); im.y = pk2((float)p1i, (float)wi);
                PW[idx] = re; PW[idx + 1] = im;
                const double nr = wr * a4r - wi * a4i, ni = wr * a4i + wi * a4r; wr = nr; wi = ni; } } } }
}
__device__ __forceinline__ float ret_log2g(int h) { return log2f(1.0f - exp2f(-5.0f - (float)h)); }

__device__ __forceinline__ void rot8(const v4u a, const v4u b, const GAS float* cs, const GAS float* sn, float sc, float (&o1)[8], float (&o2)[8]) {
    const f32x4 c0 = ((const GAS f32x4*)cs)[0], c1 = ((const GAS f32x4*)cs)[1], s0 = ((const GAS f32x4*)sn)[0], s1 = ((const GAS f32x4*)sn)[1];
    const float c[8] = {c0.x, c0.y, c0.z, c0.w, c1.x, c1.y, c1.z, c1.w}, s[8] = {s0.x, s0.y, s0.z, s0.w, s1.x, s1.y, s1.z, s1.w};
    const unsigned aw[4] = {a.x, a.y, a.z, a.w}, bw[4] = {b.x, b.y, b.z, b.w};
#pragma unroll
    for (int j = 0; j < 4; ++j) { const float x1l = bflo(aw[j]), x1h = bfhi(aw[j]), x2l = bflo(bw[j]), x2h = bfhi(bw[j]);
        o1[2 * j] = (x1l * c[2 * j] - x2l * s[2 * j]) * sc; o1[2 * j + 1] = (x1h * c[2 * j + 1] - x2h * s[2 * j + 1]) * sc;
        o2[2 * j] = (x2l * c[2 * j] + x1l * s[2 * j]) * sc; o2[2 * j + 1] = (x2h * c[2 * j + 1] + x1h * s[2 * j + 1]) * sc; }
}
__device__ __forceinline__ void ret_stage_rot_qk(const Frame& F, LAS unsigned char* qimg, LAS unsigned char* kimg, const GAS bf16* qsrc, const GAS bf16* ksrc, int pos0, float ksc) {
    const GAS float* COS = (const GAS float*)(F.ws + WS_ROPE); const GAS float* SIN = COS + NPOS * 128;
#pragma unroll 1
    for (int it0 = 0; it0 < 4; it0 += 2) {
        v4u qa[2], qb[2], ka[2], kb[2]; f32x4 c0[2], c1[2], s0[2], s1[2];
#pragma unroll
        for (int u = 0; u < 2; ++u) { const int item = F.tid + NTHR * (it0 + u), m = item >> 4, f8 = item & 15;
            const GAS bf16* qp = qsrc + (size_t)m * INW + 8 * f8; const GAS bf16* kp = ksrc + (size_t)m * INW + 8 * f8;
            qa[u] = *(const GAS v4u*)qp; qb[u] = *(const GAS v4u*)(qp + 128); ka[u] = *(const GAS v4u*)kp; kb[u] = *(const GAS v4u*)(kp + 128);
            const GAS float* cp = COS + (size_t)(pos0 + m) * 128 + 8 * f8; const GAS float* sp = SIN + (size_t)(pos0 + m) * 128 + 8 * f8;
            c0[u] = *(const GAS f32x4*)cp; c1[u] = *(const GAS f32x4*)(cp + 4); s0[u] = *(const GAS f32x4*)sp; s1[u] = *(const GAS f32x4*)(sp + 4); }
#pragma unroll
        for (int u = 0; u < 2; ++u) { const int item = F.tid + NTHR * (it0 + u), m = item >> 4, f8 = item & 15;
            const float c[8] = {c0[u].x, c0[u].y, c0[u].z, c0[u].w, c1[u].x, c1[u].y, c1[u].z, c1[u].w}, sn[8] = {s0[u].x, s0[u].y, s0[u].z, s0[u].w, s1[u].x, s1[u].y, s1[u].z, s1[u].w};
#pragma unroll
            for (int w = 0; w < 2; ++w) {
                const v4u a = w ? ka[u] : qa[u], b = w ? kb[u] : qb[u]; const float sc = w ? ksc : 1.0f;
                const unsigned aw[4] = {a.x, a.y, a.z, a.w}, bw[4] = {b.x, b.y, b.z, b.w}; unsigned o1[4], o2[4];
#pragma unroll
                for (int j = 0; j < 4; ++j) { const float x1l = bflo(aw[j]), x1h = bfhi(aw[j]), x2l = bflo(bw[j]), x2h = bfhi(bw[j]);
                    o1[j] = pk2((x1l * c[2 * j] - x2l * sn[2 * j]) * sc, (x1h * c[2 * j + 1] - x2h * sn[2 * j + 1]) * sc);
                    o2[j] = pk2((x2l * c[2 * j] + x1l * sn[2 * j]) * sc, (x2h * c[2 * j + 1] + x1h * sn[2 * j + 1]) * sc); }
                LAS unsigned char* img = w ? kimg : qimg; v4u w1, w2; w1.x = o1[0]; w1.y = o1[1]; w1.z = o1[2]; w1.w = o1[3]; w2.x = o2[0]; w2.y = o2[1]; w2.z = o2[2]; w2.w = o2[3];
                *(LAS v4u*)(img + m * 528 + 16 * f8) = w1; *(LAS v4u*)(img + m * 528 + 256 + 16 * f8) = w2; } }
    }
}
__device__ __forceinline__ void ret_stage_vT(const Frame& F, LAS unsigned char* img, const GAS bf16* src) {
    const int m = F.tid >> 2, e8l = F.tid & 3; v4u a[8];
#pragma unroll
    for (int it = 0; it < 8; ++it) a[it] = *(const GAS v4u*)(src + (size_t)m * INW + 8 * (e8l + 4 * it));
#pragma unroll
    for (int it = 0; it < 8; ++it) { const int e8 = e8l + 4 * it; const unsigned aw[4] = {a[it].x, a[it].y, a[it].z, a[it].w};
#pragma unroll
        for (int j = 0; j < 4; ++j) { *(LAS bf16*)(img + (8 * e8 + 2 * j) * 272 + 2 * m) = (bf16)(aw[j] & 0xffffu); *(LAS bf16*)(img + (8 * e8 + 2 * j + 1) * 272 + 2 * m) = (bf16)(aw[j] >> 16); } }
}

__device__ __forceinline__ void ret_scan_unit(const Frame& F, int e_layer, int b, int h, int dq, int eq) {
    const GAS bf16* PROJ = (const GAS bf16*)(F.ws + WS_PROJ);
    const GAS float* COS = (const GAS float*)(F.ws + WS_ROPE); const GAS float* SIN = COS + NPOS * 128;
    GAS bf16* SB = (GAS bf16*)(F.ws + WS_UT) + (size_t)(b * RH + h) * (NCH - 1) * 65536;
    const float lg2 = ret_log2g(h), dec = exp2f(128.0f * lg2);
    const int fr = F.lane & 15, fq = F.lane >> 4, db = F.wave >> 1, eb0 = 2 * (F.wave & 1);
    const int km = F.tid >> 2, kf4 = F.tid & 3, d1 = 32 * dq + 8 * kf4;
    const float ksc = 0.0625f * exp2f((float)(127 - km) * lg2);
    const GAS bf16* kp = PROJ + (size_t)(b * SEQ + km) * INW + 1024 + h * 256 + d1;
    const GAS float* cp = COS + (size_t)km * 128 + d1; const GAS float* sp = SIN + (size_t)km * 128 + d1;
    const GAS bf16* vp0 = PROJ + (size_t)(b * SEQ + km) * INW + 2048 + h * 256 + 64 * eq + 8 * kf4;
    v4u ka, kb, va, vb; f32x4 c0, c1, s0, s1;
    ka = *(const GAS v4u*)kp; kb = *(const GAS v4u*)(kp + 128); c0 = *(const GAS f32x4*)cp; c1 = *(const GAS f32x4*)(cp + 4); s0 = *(const GAS f32x4*)sp; s1 = *(const GAS f32x4*)(sp + 4);
    va = *(const GAS v4u*)vp0; vb = *(const GAS v4u*)(vp0 + 32);
    f32x4 acc[2] = {(f32x4){0.f, 0.f, 0.f, 0.f}, (f32x4){0.f, 0.f, 0.f, 0.f}};
    const int dl0 = 16 * db + 4 * fq, dg0 = dl0 < 32 ? 32 * dq + dl0 : 128 + 32 * dq + dl0 - 32;
    __syncthreads();
#pragma unroll 1
    for (int c = 0; c < NCH; ++c) {
        LAS unsigned char* KT = F.lds + (c & 1) * 34816; LAS unsigned char* VT = KT + 17408;
        if (c > 0) {
#pragma unroll
            for (int t = 0; t < 2; ++t) { v2u w; w.x = pk2(acc[t][0], acc[t][1]); w.y = pk2(acc[t][2], acc[t][3]);
                *(GAS v2u*)(SB + ((size_t)(c - 1) * 256 + 64 * eq + 16 * (eb0 + t) + fr) * 256 + dg0) = w; } }
        {
            const float cc[8] = {c0.x, c0.y, c0.z, c0.w, c1.x, c1.y, c1.z, c1.w}, ss[8] = {s0.x, s0.y, s0.z, s0.w, s1.x, s1.y, s1.z, s1.w};
            const unsigned aw[4] = {ka.x, ka.y, ka.z, ka.w}, bw[4] = {kb.x, kb.y, kb.z, kb.w};
#pragma unroll
            for (int j = 0; j < 8; ++j) { const float x1 = (j & 1) ? bfhi(aw[j >> 1]) : bflo(aw[j >> 1]), x2 = (j & 1) ? bfhi(bw[j >> 1]) : bflo(bw[j >> 1]);
                *(LAS bf16*)(KT + (8 * kf4 + j) * 272 + 2 * km) = (bf16)f2bf((x1 * cc[j] - x2 * ss[j]) * ksc);
                *(LAS bf16*)(KT + (32 + 8 * kf4 + j) * 272 + 2 * km) = (bf16)f2bf((x2 * cc[j] + x1 * ss[j]) * ksc); }
            const unsigned vw[8] = {va.x, va.y, va.z, va.w, vb.x, vb.y, vb.z, vb.w};
#pragma unroll
            for (int j = 0; j < 8; ++j) { const int e8 = kf4 + 4 * (j >> 2);
                *(LAS bf16*)(VT + (8 * e8 + 2 * (j & 3)) * 272 + 2 * km) = (bf16)(vw[j] & 0xffffu); *(LAS bf16*)(VT + (8 * e8 + 2 * (j & 3) + 1) * 272 + 2 * km) = (bf16)(vw[j] >> 16); }
        }
        if (c + 1 < NCH) {
            const size_t ro = (size_t)(c + 1) * CH * INW; const size_t po = (size_t)(c + 1) * CH * 128;
            ka = *(const GAS v4u*)(kp + ro); kb = *(const GAS v4u*)(kp + ro + 128); c0 = *(const GAS f32x4*)(cp + po); c1 = *(const GAS f32x4*)(cp + po + 4); s0 = *(const GAS f32x4*)(sp + po); s1 = *(const GAS f32x4*)(sp + po + 4);
            va = *(const GAS v4u*)(vp0 + ro); vb = *(const GAS v4u*)(vp0 + ro + 32); }
        asm volatile("s_waitcnt lgkmcnt(0)" ::: "memory"); __builtin_amdgcn_s_barrier(); asm volatile("" ::: "memory");
        acc[0] = acc[0] * dec; acc[1] = acc[1] * dec;
#pragma unroll
        for (int ks = 0; ks < 4; ++ks) { const bf16x8 af = *(const LAS bf16x8*)(KT + (16 * db + fr) * 272 + (32 * ks + 8 * fq) * 2);
#pragma unroll
            for (int t = 0; t < 2; ++t) { const bf16x8 bv = *(const LAS bf16x8*)(VT + (16 * (eb0 + t) + fr) * 272 + (32 * ks + 8 * fq) * 2); acc[t] = MFMA32(af, bv, acc[t]); } }
    }
    GAS float* o = F.out + O_RETP + (size_t)((e_layer * BATCH + b) * RH + h) * 65536;
#pragma unroll
    for (int t = 0; t < 2; ++t)
#pragma unroll
        for (int r = 0; r < 4; ++r) o[(size_t)(dg0 + r) * 256 + 64 * eq + 16 * (eb0 + t) + fr] = acc[t][r];
}

__device__ __forceinline__ void ret_c_unit(const Frame& F, int b, int h, int c) {
    LAS unsigned char* QS = F.lds; LAS unsigned char* R2 = F.lds + 67584;
    const GAS bf16* PROJ = (const GAS bf16*)(F.ws + WS_PROJ); const int row0 = b * SEQ + CH * c;
    const float lg2 = ret_log2g(h);
    __syncthreads();
    ret_stage_rot_qk(F, QS, R2, PROJ + (size_t)row0 * INW + h * 256, PROJ + (size_t)row0 * INW + 1024 + h * 256, CH * c, 0.0625f);
    __syncthreads();
    const int fr = F.lane & 15, fq = F.lane >> 4, w = F.wave;
    const int nl = 16 * w + fr;
    bf16x8 pf[4];
    { f32x4 ap[8];
#pragma unroll
      for (int mb = 0; mb < 8; ++mb) ap[mb] = (f32x4){0.f, 0.f, 0.f, 0.f};
#pragma unroll
      for (int ks = 0; ks < 8; ++ks) { const bf16x8 qf = *(const LAS bf16x8*)(QS + nl * 528 + (32 * ks + 8 * fq) * 2);
#pragma unroll
          for (int mb = 0; mb < 8; ++mb) { const bf16x8 kf = *(const LAS bf16x8*)(R2 + (16 * mb + fr) * 528 + (32 * ks + 8 * fq) * 2); ap[mb] = MFMA32(kf, qf, ap[mb]); }
          __builtin_amdgcn_sched_barrier(0); }
#pragma unroll
      for (int mb = 0; mb < 8; ++mb)
#pragma unroll
          for (int r = 0; r < 4; ++r) { const int m = 16 * mb + 4 * fq + r, df = nl - m; ap[mb][r] = df >= 0 ? ap[mb][r] * exp2f((float)df * lg2) : 0.f; }
#pragma unroll
      for (int s = 0; s < 4; ++s) { v4u t; t.x = pk2(ap[2 * s][0], ap[2 * s][1]); t.y = pk2(ap[2 * s][2], ap[2 * s][3]); t.z = pk2(ap[2 * s + 1][0], ap[2 * s + 1][1]); t.w = pk2(ap[2 * s + 1][2], ap[2 * s + 1][3]);
          pf[s] = __builtin_bit_cast(bf16x8, t); }
      asm volatile("" : "+v"(pf[0]), "+v"(pf[1]), "+v"(pf[2]), "+v"(pf[3])); }
    f32x4 acc[16];
#pragma unroll
    for (int eb = 0; eb < 16; ++eb) acc[eb] = (f32x4){0.f, 0.f, 0.f, 0.f};
#ifndef RC_NO_S
    if (c > 0) {
        const GAS bf16* SB = (const GAS bf16*)(F.ws + WS_UT) + ((size_t)(b * RH + h) * (NCH - 1) + c - 1) * 65536;
#pragma unroll
        for (int half = 0; half < 2; ++half) {
            __syncthreads();
            { const GAS bf16* sp = SB + (size_t)(128 * half + (F.tid >> 5)) * 256 + 8 * (F.tid & 31); LAS unsigned char* dp = R2 + (F.tid >> 5) * 528 + 16 * (F.tid & 31);
#pragma unroll 1
              for (int ih = 0; ih < 2; ++ih) { v4u t[4];
#pragma unroll
                  for (int it = 0; it < 4; ++it) t[it] = *(const GAS v4u*)(sp + (size_t)(16 * (4 * ih + it)) * 256);
#pragma unroll
                  for (int it = 0; it < 4; ++it) *(LAS v4u*)(dp + 16 * (4 * ih + it) * 528) = t[it]; } }
            __syncthreads();
#pragma unroll
            for (int ks = 0; ks < 8; ++ks) { const bf16x8 qf = *(const LAS bf16x8*)(QS + nl * 528 + (32 * ks + 8 * fq) * 2);
#pragma unroll
                for (int eb = 0; eb < 8; ++eb) { const bf16x8 sf = *(const LAS bf16x8*)(R2 + (16 * eb + fr) * 528 + (32 * ks + 8 * fq) * 2); acc[8 * half + eb] = MFMA32(sf, qf, acc[8 * half + eb]); }
                __builtin_amdgcn_sched_barrier(0); }
            asm volatile("" : "+v"(acc[8 * half + 0]), "+v"(acc[8 * half + 1]), "+v"(acc[8 * half + 2]), "+v"(acc[8 * half + 3]), "+v"(acc[8 * half + 4]), "+v"(acc[8 * half + 5]), "+v"(acc[8 * half + 6]), "+v"(acc[8 * half + 7]));
        }
        const float qd = exp2f((float)(nl + 1) * lg2);
#pragma unroll
        for (int eb = 0; eb < 16; ++eb) acc[eb] = acc[eb] * qd;
    }
#endif
#ifndef RC_NO_PV
    __syncthreads();
    ret_stage_vT(F, R2, PROJ + (size_t)row0 * INW + 2048 + h * 256);
    __syncthreads();
#pragma unroll
    for (int s = 0; s < 4; ++s)
#pragma unroll
        for (int eh = 0; eh < 2; ++eh) {
#pragma unroll
            for (int e8 = 0; e8 < 8; ++e8) { const int eb = 8 * eh + e8; const LAS unsigned char* vp = R2 + (16 * eb + fr) * 272 + (32 * s + 4 * fq) * 2;
                const v2u lo = *(const LAS v2u*)vp, hi = *(const LAS v2u*)(vp + 32); v4u t; t.x = lo.x; t.y = lo.y; t.z = hi.x; t.w = hi.y;
                acc[eb] = MFMA32(__builtin_bit_cast(bf16x8, t), pf[s], acc[eb]); }
            __builtin_amdgcn_sched_barrier(0); }
#endif
    float ss = 0.f;
#pragma unroll
    for (int eb = 0; eb < 16; ++eb) ss += (acc[eb][0] * acc[eb][0] + acc[eb][1] * acc[eb][1]) + (acc[eb][2] * acc[eb][2] + acc[eb][3] * acc[eb][3]);
    ss += __shfl_xor(ss, 16); ss += __shfl_xor(ss, 32);
    const float rstd = 1.0f / sqrtf(ss * (1.0f / 256.0f) + EPS);
    const GAS bf16* grp = PROJ + (size_t)(row0 + nl) * INW + 3072 + h * 256 + 4 * fq; GAS bf16* op = (GAS bf16*)(F.ws + WS_CAT) + (size_t)(row0 + nl) * D + h * 256 + 4 * fq;
    v2u gv[16];
#pragma unroll
    for (int eb = 0; eb < 16; ++eb) gv[eb] = *(const GAS v2u*)(grp + 16 * eb);
#pragma unroll
    for (int eb = 0; eb < 16; ++eb) { const v2u g = gv[eb];
        v2u o; o.x = pk2(acc[eb][0] * rstd * siluf_(bflo(g.x)), acc[eb][1] * rstd * siluf_(bfhi(g.x))); o.y = pk2(acc[eb][2] * rstd * siluf_(bflo(g.y)), acc[eb][3] * rstd * siluf_(bfhi(g.y)));
        *(GAS v2u*)(op + 16 * eb) = o; }
}

__device__ __forceinline__ void ret_s_unit(const Frame& F, int e_layer, int b, int h) {
    LAS float* QK = (LAS float*)F.lds;
    LAS float* VS = QK + 2048;
    LAS float* SC = VS + 1024;
    LAS float* RED = SC + 16;
    LAS float* OS = RED + 8192;
    LAS float* NRM = OS + 1024;
    const GAS bf16* PROJ = (const GAS bf16*)(F.ws + WS_PROJ); const int row0 = MP + b * DEC_T;
    const GAS float* COS = (const GAS float*)(F.ws + WS_ROPE); const GAS float* SIN = COS + NPOS * 128;
    const float lg2 = ret_log2g(h);
    __syncthreads();
    {
#pragma unroll
      for (int it = 0; it < 2; ++it) { const int item = F.tid + NTHR * it, f = item & 127, t = (item >> 7) & 3, isk = item >> 9;
          const GAS bf16* p = PROJ + (size_t)(row0 + t) * INW + isk * 1024 + h * 256; const float x1 = bf2f(p[f]), x2 = bf2f(p[128 + f]);
          const float c = COS[(SEQ + t) * 128 + f], s = SIN[(SEQ + t) * 128 + f]; float sc = isk ? 0.0625f * exp2f((float)(3 - t) * lg2) : 1.0f;
          QK[f * 8 + isk * 4 + t] = (x1 * c - x2 * s) * sc; QK[(128 + f) * 8 + isk * 4 + t] = (x2 * c + x1 * s) * sc; }
#pragma unroll
      for (int it = 0; it < 2; ++it) { const int item = F.tid + NTHR * it, e = item & 255, t = item >> 8; VS[t * 256 + e] = bf2f(PROJ[(size_t)(row0 + t) * INW + 2048 + h * 256 + e]); }
    }
    __syncthreads();
    { const int pr = F.tid >> 5, n = pr >> 2, m = pr & 3, l32 = F.tid & 31; float s = 0.f;
#pragma unroll
      for (int j = 0; j < 8; ++j) { const int d = l32 + 32 * j; s += QK[d * 8 + n] * QK[d * 8 + 4 + m]; }
#pragma unroll
      for (int o = 1; o < 32; o <<= 1) s += __shfl_xor(s, o);
      if (l32 == 0) { s *= exp2f(-(float)(3 - m) * lg2); SC[n * 4 + m] = n >= m ? s * exp2f((float)(n - m) * lg2) : 0.f; } }
    const int eg = F.tid & 63, dg = F.tid >> 6;
    const GAS float* s0 = F.inp(I_SRET) + ((size_t)(e_layer * DEC_B + b) * RH + h) * 65536;
    GAS float* s1 = F.out + O_RETS + ((size_t)(e_layer * DEC_B + b) * RH + h) * 65536;
    const float dec = exp2f(4.0f * lg2);
    f32x4 v[4], oa[4];
#pragma unroll
    for (int m = 0; m < 4; ++m) { v[m] = *(const LAS f32x4*)(VS + m * 256 + 4 * eg); oa[m] = (f32x4){0.f, 0.f, 0.f, 0.f}; }
    {
        f32x4 sv[4], sn4[4];
#pragma unroll
        for (int j = 0; j < 4; ++j) sv[j] = __builtin_nontemporal_load((const GAS f32x4*)(s0 + (size_t)(32 * dg + j) * 256 + 4 * eg));
#pragma unroll 1
        for (int bt = 0; bt < 8; ++bt) { const int d0 = 32 * dg + 4 * bt; const int dn = bt < 7 ? d0 + 4 : d0;
#pragma unroll
            for (int j = 0; j < 4; ++j) sn4[j] = __builtin_nontemporal_load((const GAS f32x4*)(s0 + (size_t)(dn + j) * 256 + 4 * eg));
#pragma unroll
            for (int j = 0; j < 4; ++j) { const int d = d0 + j; const f32x4 st = sv[j];
                const f32x4 q = *(const LAS f32x4*)(QK + d * 8), k = *(const LAS f32x4*)(QK + d * 8 + 4);
                oa[0] += st * q.x; oa[1] += st * q.y; oa[2] += st * q.z; oa[3] += st * q.w;
                const f32x4 sn = st * dec + v[0] * k.x + v[1] * k.y + v[2] * k.z + v[3] * k.w;
                __builtin_nontemporal_store(sn, (GAS f32x4*)(s1 + (size_t)d * 256 + 4 * eg)); }
#pragma unroll
            for (int j = 0; j < 4; ++j) sv[j] = sn4[j]; }
    }
#pragma unroll
    for (int n = 0; n < 4; ++n) *(LAS f32x4*)(RED + (dg * 4 + n) * 256 + 4 * eg) = oa[n];
    __syncthreads();
    {
#pragma unroll
      for (int it = 0; it < 2; ++it) { const int item = F.tid + NTHR * it, e = item & 255, n = item >> 8; float s = 0.f;
#pragma unroll
          for (int g8 = 0; g8 < 8; ++g8) s += RED[(g8 * 4 + n) * 256 + e];
          s *= exp2f((float)(n + 1) * lg2);
#pragma unroll
          for (int m = 0; m < 4; ++m) s += SC[n * 4 + m] * VS[m * 256 + e];
          OS[n * 256 + e] = s; } }
    __syncthreads();
    if (F.wave < 4) { const int n = F.wave; float ss = 0.f;
#pragma unroll
        for (int j = 0; j < 4; ++j) { const float x = OS[n * 256 + F.lane + 64 * j]; ss += x * x; }
        ss = wave_sum(ss); if (F.lane == 0) NRM[n] = 1.0f / sqrtf(ss * (1.0f / 256.0f) + EPS); }
    __syncthreads();
#pragma unroll
    for (int it = 0; it < 2; ++it) { const int item = F.tid + NTHR * it, e = item & 255, n = item >> 8;
        const float g = bf2f(PROJ[(size_t)(row0 + n) * INW + 3072 + h * 256 + e]);
        ((GAS bf16*)(F.ws + WS_CAT))[(size_t)(row0 + n) * D + h * 256 + e] = (bf16)f2bf(OS[n * 256 + e] * NRM[n] * siluf_(g)); }
}
template <int MODE>
__device__ __forceinline__ void lru_unit(const Frame& F, int e_layer, int tile_b, int tile_c, int n, bool stage_w) {
    LAS unsigned char* XC = F.lds;
    LAS unsigned char* WT = F.lds + 34816;
    const GAS bf16* PROJ = (const GAS bf16*)(F.ws + WS_PROJ);
    const int row0 = MODE == 2 ? MP + 128 * tile_c : tile_b * SEQ + CH * tile_c;
    __syncthreads();
    if (stage_w) { const GAS bf16* LW = (const GAS bf16*)(F.ws + WS_LRUW) + (size_t)(e_layer * 8 + n) * 256 * 128; v4u t[8];
#pragma unroll
      for (int it = 0; it < 8; ++it) { const int item = F.tid + NTHR * it, r = item >> 4, c16 = item & 15; t[it] = *(const GAS v4u*)(LW + r * 128 + 8 * c16); }
#pragma unroll
      for (int it = 0; it < 8; ++it) { const int item = F.tid + NTHR * it, r = item >> 4, c16 = item & 15; *(LAS v4u*)(WT + r * 272 + 16 * c16) = t[it]; } }
    { const int c8 = F.tid & 15;
      const GAS float* cw = F.inp(I_CW) + (size_t)e_layer * 4 * LRU_W + n * 128 + 8 * c8; const GAS float* cb = F.inp(I_CB) + (size_t)e_layer * LRU_W + n * 128 + 8 * c8;
      float wv[4][8], bias[8];
      { const f32x4 b0 = *(const GAS f32x4*)cb, b1 = *(const GAS f32x4*)(cb + 4); bias[0] = b0.x; bias[1] = b0.y; bias[2] = b0.z; bias[3] = b0.w; bias[4] = b1.x; bias[5] = b1.y; bias[6] = b1.z; bias[7] = b1.w; }
#pragma unroll
      for (int kk = 0; kk < 4; ++kk) { const f32x4 w0 = *(const GAS f32x4*)(cw + (3 - kk) * LRU_W), w1 = *(const GAS f32x4*)(cw + (3 - kk) * LRU_W + 4);
          wv[kk][0] = w0.x; wv[kk][1] = w0.y; wv[kk][2] = w0.z; wv[kk][3] = w0.w; wv[kk][4] = w1.x; wv[kk][5] = w1.y; wv[kk][6] = w1.z; wv[kk][7] = w1.w; }
#pragma unroll 1
      for (int ih = 0; ih < 2; ++ih) {
      v4u xr[2][4];
#pragma unroll
      for (int it = 0; it < 2; ++it) { const int tok = (F.tid >> 4) + 32 * (2 * ih + it);
#pragma unroll
          for (int kk = 0; kk < 4; ++kk) { const int tq = MODE == 2 ? (tok & 3) - kk : CH * tile_c + tok - kk;
              xr[it][kk] = (v4u){0u, 0u, 0u, 0u};
              if (tq >= 0) xr[it][kk] = *(const GAS v4u*)(PROJ + (size_t)(row0 + tok - kk) * INW + 4096 + n * 128 + 8 * c8); } }
#pragma unroll
      for (int it = 0; it < 2; ++it) { const int tok = (F.tid >> 4) + 32 * (2 * ih + it);
          float acc[8];
#pragma unroll
          for (int j = 0; j < 8; ++j) acc[j] = bias[j];
#pragma unroll
          for (int kk = 0; kk < 4; ++kk) { const v4u a = xr[it][kk]; float x[8] = {bflo(a.x), bfhi(a.x), bflo(a.y), bfhi(a.y), bflo(a.z), bfhi(a.z), bflo(a.w), bfhi(a.w)};
              if (MODE == 2) { const int tq = (tok & 3) - kk;
                  if (tq < 0) { const int bb = 32 * tile_c + (tok >> 2); const GAS float* sp = F.inp(I_SCONV) + ((size_t)(e_layer * DEC_B + bb) * 3 + (3 + tq)) * LRU_W + n * 128 + 8 * c8;
                      const f32x4 s0 = *(const GAS f32x4*)sp, s1 = *(const GAS f32x4*)(sp + 4); x[0] = s0.x; x[1] = s0.y; x[2] = s0.z; x[3] = s0.w; x[4] = s1.x; x[5] = s1.y; x[6] = s1.z; x[7] = s1.w; } }
#pragma unroll
              for (int j = 0; j < 8; ++j) acc[j] += x[j] * wv[kk][j]; }
          v4u o; o.x = pk2(acc[0], acc[1]); o.y = pk2(acc[2], acc[3]); o.z = pk2(acc[4], acc[5]); o.w = pk2(acc[6], acc[7]);
          *(LAS v4u*)(XC + tok * 272 + 16 * c8) = o; } } }
    __syncthreads();
    const int fr = F.lane & 15, fq = F.lane >> 4, w = F.wave;
    f32x4 aR[8], aI[8];
#pragma unroll
    for (int tb = 0; tb < 8; ++tb) { aR[tb] = (f32x4){0.f, 0.f, 0.f, 0.f}; aI[tb] = (f32x4){0.f, 0.f, 0.f, 0.f}; }
#pragma unroll
    for (int ks = 0; ks < 4; ++ks) {
        const bf16x8 br = *(const LAS bf16x8*)(WT + (16 * w + fr) * 272 + (32 * ks + 8 * fq) * 2), bi = *(const LAS bf16x8*)(WT + (128 + 16 * w + fr) * 272 + (32 * ks + 8 * fq) * 2);
#pragma unroll
        for (int tb = 0; tb < 8; ++tb) { const bf16x8 af = *(const LAS bf16x8*)(XC + (16 * tb + fr) * 272 + (32 * ks + 8 * fq) * 2);
            aR[tb] = MFMA32(af, br, aR[tb]); aI[tb] = MFMA32(af, bi, aI[tb]); }
    }
    const int chl = 16 * w + fr, ch = n * 128 + chl;
    const float cc = ((const GAS float*)(F.ws + WS_LRUC))[e_layer * LRU_W + ch], ba = F.inp(I_BA)[e_layer * LRU_W + ch], bx = F.inp(I_BX)[e_layer * LRU_W + ch];
    float H = 0.f, Aprod = 1.f;
    if (MODE == 1) {
        const GAS float* SA = (const GAS float*)(F.ws + WS_LSA) + (size_t)tile_b * NCH * LRU_W + ch; const GAS float* SBm = (const GAS float*)(F.ws + WS_LSB) + (size_t)tile_b * NCH * LRU_W + ch;
        float av[NCH - 1], bv[NCH - 1];
#pragma unroll
        for (int cc = 0; cc < NCH - 1; ++cc) { av[cc] = 1.f; bv[cc] = 0.f; if (cc < tile_c) { av[cc] = SA[(size_t)cc * LRU_W]; bv[cc] = SBm[(size_t)cc * LRU_W]; } }
#pragma unroll
        for (int cc = 0; cc < NCH - 1; ++cc) H = av[cc] * H + bv[cc]; }
    GAS bf16* CAT = (GAS bf16*)(F.ws + WS_CAT);
    bf16 yln[4] = {0, 0, 0, 0};
    if (MODE != 0) {
#pragma unroll
        for (int r = 0; r < 4; ++r) yln[r] = PROJ[(size_t)(row0 + 4 * fq + r) * INW + 5120 + ch]; }
#pragma unroll
    for (int tb = 0; tb < 8; ++tb) {
        bf16 ylc[4];
#pragma unroll
        for (int r = 0; r < 4; ++r) ylc[r] = yln[r];
        if (MODE != 0 && tb < 7) {
#pragma unroll
            for (int r = 0; r < 4; ++r) yln[r] = PROJ[(size_t)(row0 + 16 * (tb + 1) + 4 * fq + r) * INW + 5120 + ch]; }
        float a[4], bt[4];
#pragma unroll
        for (int r = 0; r < 4; ++r) { const int tok = 16 * tb + 4 * fq + r;
            const float rr = sigmoidf_(aR[tb][r] + ba), ii = sigmoidf_(aI[tb][r] + bx), la = -cc * rr;
            a[r] = __builtin_amdgcn_exp2f(1.44269504f * la); const float m2 = 1.0f - a[r] * a[r];
            const float x = bf2f(*(const LAS bf16*)(XC + tok * 272 + 2 * chl));
            bt[r] = sqrtf(fmaxf(m2, 0.f)) * ii * x; }
        if (MODE == 2) {
            const int bb = 32 * tile_c + 4 * tb + fq; float h = F.inp(I_SLRU)[(size_t)(e_layer * DEC_B + bb) * LRU_W + ch];
#pragma unroll
            for (int r = 0; r < 4; ++r) { h = a[r] * h + bt[r]; const size_t row = (size_t)(row0 + 16 * tb + 4 * fq + r);
                const float yl = bf2f(ylc[r]); CAT[row * D + 1024 + ch] = (bf16)f2bf(geluf_(yl) * h); }
            F.out[O_LRUS + (size_t)(e_layer * DEC_B + bb) * LRU_W + ch] = h;
        } else {
            float As = a[0], Bs = bt[0];
#pragma unroll
            for (int r = 1; r < 4; ++r) { Bs = a[r] * Bs + bt[r]; As *= a[r]; }
            float Ai = As, Bi = Bs;
            { const float A1 = __shfl_up(Ai, 16), B1 = __shfl_up(Bi, 16); if (fq >= 1) { Bi = Ai * B1 + Bi; Ai = Ai * A1; } }
            { const float A2 = __shfl_up(Ai, 32), B2 = __shfl_up(Bi, 32); if (fq >= 2) { Bi = Ai * B2 + Bi; Ai = Ai * A2; } }
            float Ae = __shfl_up(Ai, 16), Be = __shfl_up(Bi, 16); if (fq == 0) { Ae = 1.f; Be = 0.f; }
            const float At = __shfl(Ai, 48 + fr), Bt = __shfl(Bi, 48 + fr);
            if (MODE == 1) { float h = Ae * H + Be;
#pragma unroll
                for (int r = 0; r < 4; ++r) { h = a[r] * h + bt[r]; const size_t row = (size_t)(row0 + 16 * tb + 4 * fq + r);
                    const float yl = bf2f(ylc[r]); CAT[row * D + 1024 + ch] = (bf16)f2bf(geluf_(yl) * h); } }
            H = At * H + Bt; Aprod *= At;
        }
    }
    if (MODE == 1 && tile_c == NCH - 1 && fq == 0) F.out[O_LRUP + (size_t)(e_layer * BATCH + tile_b) * LRU_W + ch] = H;
    if (MODE == 0 && fq == 0) { ((GAS float*)(F.ws + WS_LSA))[(size_t)(tile_b * NCH + tile_c) * LRU_W + ch] = Aprod; ((GAS float*)(F.ws + WS_LSB))[(size_t)(tile_b * NCH + tile_c) * LRU_W + ch] = H; }
    if (MODE == 2) {
#pragma unroll 1
        for (int it = 0; it < 24; ++it) { const int item = F.tid + NTHR * it, chx = item & 127, i3 = (item >> 7) % 3, bl = item / 384;
            const int bb = 32 * tile_c + bl; F.out[O_CONVS + ((size_t)(e_layer * DEC_B + bb) * 3 + i3) * LRU_W + n * 128 + chx] = bf2f(PROJ[(size_t)(MP + bb * 4 + 1 + i3) * INW + 4096 + n * 128 + chx]); }
    } else if (MODE == 1 && tile_c == NCH - 1) {
        if (F.tid < 384) { const int chx = F.tid & 127, i3 = F.tid >> 7;
            F.out[O_CONVP + ((size_t)(e_layer * BATCH + tile_b) * 3 + i3) * LRU_W + n * 128 + chx] = bf2f(PROJ[(size_t)(tile_b * SEQ + SEQ - 3 + i3) * INW + 4096 + n * 128 + chx]); }
    }
}
template <int MODE>
__device__ __forceinline__ void s5_wave_unit(const Frame& F, int o_layer, int pb, int pc, int g) {
    LAS float* BU = (LAS float*)(F.lds + F.wave * 12800);
    LAS unsigned char* SS = F.lds + F.wave * 12800 + 8448;
    const int lane = F.lane, fr = lane & 15, fq = lane >> 4;
    const GAS bf16* XN = (const GAS bf16*)(F.ws + WS_XN); GAS bf16* CAT = (GAS bf16*)(F.ws + WS_CAT);
    const GAS bf16* BB = (const GAS bf16*)(F.ws + WS_S5BB) + (size_t)(o_layer * SG + g) * 128 * 16;
    const GAS bf16* CM = (const GAS bf16*)(F.ws + WS_S5CM) + (size_t)(o_layer * SG + g) * 16 * 128;
    bf16x4 bb[8];
#pragma unroll
    for (int nb = 0; nb < 8; ++nb) bb[nb] = __builtin_bit_cast(bf16x4, *(const GAS v2u*)(BB + (16 * nb + fr) * 16 + 4 * fq));
    bf16x8 cm[4]; f32x4 dd = (f32x4){0.f, 0.f, 0.f, 0.f};
    if (MODE != 0) {
#pragma unroll
        for (int ks = 0; ks < 4; ++ks) cm[ks] = __builtin_bit_cast(bf16x8, *(const GAS v4u*)(CM + fr * 128 + 32 * ks + 8 * fq));
        dd = *(const GAS f32x4*)(F.inp(I_SD) + (size_t)o_layer * D + 16 * g + 4 * fq); }
    const f32x4 ab = *(const GAS f32x4*)((const GAS float*)(F.ws + WS_S5AB) + (size_t)((o_layer * SG + g) * SP + lane) * 4);
    const float ar = ab.x, ai = ab.y;
    float sr = 0.f, si = 0.f;
    GAS float* LOC = (GAS float*)(F.ws + WS_S5LOC);
    if (MODE == 1) {
        const float a8r = ab.z, a8i = ab.w; const GAS f32x2* lp = (const GAS f32x2*)(LOC + ((size_t)pb * NCH * 8192 + g * SP + lane) * 2);
        f32x2 lv[NCH - 1];
#pragma unroll
        for (int cc = 0; cc < NCH - 1; ++cc) { lv[cc] = (f32x2){0.f, 0.f}; if (cc < pc) lv[cc] = lp[(size_t)cc * 8192]; }
#pragma unroll
        for (int cc = 0; cc < NCH - 1; ++cc) if (cc < pc) { const float nr = a8r * sr - a8i * si + lv[cc].x, ni = a8r * si + a8i * sr + lv[cc].y; sr = nr; si = ni; } }
    constexpr int nsub = MODE == 2 ? 1 : 8;
    const int rowbase = MODE == 2 ? MP + 16 * pc : pb * SEQ + CH * pc;
    v2u uall[nsub], oall[nsub];
#pragma unroll
    for (int sub = 0; sub < nsub; ++sub) uall[sub] = *(const GAS v2u*)(XN + (size_t)(rowbase + 16 * sub + fr) * D + 16 * g + 4 * fq);
#pragma unroll
    for (int sub = 0; sub < nsub; ++sub) {
        const int r0 = rowbase + 16 * sub;
        const v2u uraw = uall[sub];
        const bf16x4 uf = __builtin_bit_cast(bf16x4, uraw);
#pragma unroll
        for (int nb = 0; nb < 8; ++nb) { const f32x4 d = MFMA16(bb[nb], uf, ((f32x4){0.f, 0.f, 0.f, 0.f}));
            *(LAS f32x4*)(BU + fr * 132 + 16 * nb + 4 * fq) = d; }
        float isr[4], isi[4];
        if (MODE == 2) {
#pragma unroll
            for (int q = 0; q < 4; ++q) { const size_t si0 = ((size_t)(o_layer * DEC_B + 4 * pc + q) * SG + g) * SP + lane; isr[q] = F.inp(I_SSRE)[si0]; isi[q] = F.inp(I_SSIM)[si0]; } }
        float br[16], bi[16];
#pragma unroll
        for (int t = 0; t < 16; ++t) { const f32x2 bv = *(const LAS f32x2*)(BU + t * 132 + 2 * lane); br[t] = bv.x; bi[t] = bv.y; }
#pragma unroll
        for (int t = 0; t < 16; ++t) {
            if (MODE == 2 && (t & 3) == 0) { sr = isr[t >> 2]; si = isi[t >> 2]; }
            const float nr = ar * sr - ai * si + br[t], ni = ar * si + ai * sr + bi[t]; sr = nr; si = ni;
            if (MODE != 0) *(LAS u32a*)(SS + t * 272 + 4 * lane) = pk2(sr, si);
            if (MODE == 2 && (t & 3) == 3) { const int bbt = 4 * pc + (t >> 2); const size_t so = ((size_t)(o_layer * DEC_B + bbt) * SG + g) * SP + lane; F.out[O_SRES + so] = sr; F.out[O_SIMS + so] = si; }
        }
        if (MODE != 0) {
            f32x4 y = (f32x4){0.f, 0.f, 0.f, 0.f};
#pragma unroll
            for (int ks = 0; ks < 4; ++ks) { const bf16x8 sf = *(const LAS bf16x8*)(SS + fr * 272 + (32 * ks + 8 * fq) * 2); y = MFMA32(cm[ks], sf, y); }
            const float u0 = bflo(uraw.x), u1 = bfhi(uraw.x), u2 = bflo(uraw.y), u3 = bfhi(uraw.y);
            v2u o; o.x = pk2(geluf_(y[0] + dd.x * u0), geluf_(y[1] + dd.y * u1)); o.y = pk2(geluf_(y[2] + dd.z * u2), geluf_(y[3] + dd.w * u3));
            oall[sub] = o;
        }
    }
    if (MODE != 0) {
#pragma unroll
        for (int sub = 0; sub < nsub; ++sub) *(GAS v2u*)(CAT + (size_t)(rowbase + 16 * sub + fr) * D + 16 * g + 4 * fq) = oall[sub]; }
    if (MODE == 0) *(GAS f32x2*)(LOC + ((size_t)(pb * NCH + pc) * 8192 + g * SP + lane) * 2) = (f32x2){sr, si};
    if (MODE == 1 && pc == NCH - 1) { const size_t so = (size_t)(o_layer * BATCH + pb) * 8192 + g * SP + lane; F.out[O_SREP + so] = sr; F.out[O_SIMP + so] = si; }
}

#define SWZX(x, pat) __builtin_bit_cast(float, __builtin_amdgcn_ds_swizzle(__builtin_bit_cast(int, (x)), (pat)))
__device__ __forceinline__ void s5_end_units(const Frame& F, int o_layer, int g, int half, int piece0, int pstep) {
    const int lane = F.lane, fr = lane & 15, fq = lane >> 4;
    const GAS bf16* XN = (const GAS bf16*)(F.ws + WS_XN);
    const GAS v2u* T = (const GAS v2u*)(F.ws + WS_S5PW) + ((size_t)(o_layer * SG + g) * 64 + 4 * half) * 64 + lane;
    bf16x4 tab[8][4];
#pragma unroll
    for (int sub = 0; sub < 8; ++sub)
#pragma unroll
        for (int mb = 0; mb < 4; ++mb) tab[sub][mb] = __builtin_bit_cast(bf16x4, T[(size_t)(sub * 8 + mb) * 64]);
    const GAS bf16* BB = (const GAS bf16*)(F.ws + WS_S5BB) + (size_t)(o_layer * SG + g) * 128 * 16;
    float bre[8], bim[8];
#pragma unroll
    for (int j = 0; j < 8; ++j) { const int p = 8 * (4 * half + (j >> 1)) + 2 * fq + (j & 1);
        bre[j] = __builtin_bit_cast(float, (unsigned)BB[(2 * p) * 16 + fr] << 16); bim[j] = __builtin_bit_cast(float, (unsigned)BB[(2 * p + 1) * 16 + fr] << 16); }
    v2u idw; { const int d = fr - 4 * fq; idw.x = d == 0 ? 0x3F80u : d == 1 ? 0x3F800000u : 0u; idw.y = d == 2 ? 0x3F80u : d == 3 ? 0x3F800000u : 0u; }
    const bf16x4 ident = __builtin_bit_cast(bf16x4, idw);
    GAS float* LOC = (GAS float*)(F.ws + WS_S5LOC);
    v2u ub[3][8];
#define S5E_LOADU(buf, pcx) { const int rb_ = ((pcx) >> 4) * SEQ + CH * ((pcx) & 15); _Pragma("unroll") for (int sub = 0; sub < 8; ++sub) buf[sub] = *(const GAS v2u*)(XN + (size_t)(rb_ + 16 * sub + fr) * D + 16 * g + 4 * fq); }
    S5E_LOADU(ub[0], piece0); S5E_LOADU(ub[1], piece0 + pstep);
#pragma unroll
    for (int it = 0; it < 8; ++it) { const int pc = piece0 + pstep * it;
        if (it + 2 < 8) S5E_LOADU(ub[(it + 2) % 3], piece0 + pstep * (it + 2));
        v2u (&uall)[8] = ub[it % 3];
        f32x4 acc[4];
#pragma unroll
        for (int mb = 0; mb < 4; ++mb) acc[mb] = (f32x4){0.f, 0.f, 0.f, 0.f};
#pragma unroll
        for (int sub = 0; sub < 8; ++sub) {
            const f32x4 d = MFMA16(__builtin_bit_cast(bf16x4, uall[sub]), ident, ((f32x4){0.f, 0.f, 0.f, 0.f}));
            v2u utw; utw.x = pk2(d[0], d[1]); utw.y = pk2(d[2], d[3]);
            const bf16x4 ut = __builtin_bit_cast(bf16x4, utw);
#pragma unroll
            for (int mb = 0; mb < 4; ++mb) acc[mb] = MFMA16(tab[sub][mb], ut, acc[mb]);
        }
        float v[16];
#pragma unroll
        for (int j = 0; j < 8; ++j) { const float wr = acc[j >> 1][2 * (j & 1)], wi = acc[j >> 1][2 * (j & 1) + 1];
            v[2 * j] = bre[j] * wr - bim[j] * wi; v[2 * j + 1] = bre[j] * wi + bim[j] * wr; }
#pragma unroll
        for (int i = 0; i < 8; ++i) { const bool up = (fr & 8) != 0; const float send = up ? v[i] : v[8 + i], keep = up ? v[8 + i] : v[i]; v[i] = keep + SWZX(send, 0x201F); }
#pragma unroll
        for (int i = 0; i < 4; ++i) { const bool up = (fr & 4) != 0; const float send = up ? v[i] : v[4 + i], keep = up ? v[4 + i] : v[i]; v[i] = keep + SWZX(send, 0x101F); }
#pragma unroll
        for (int i = 0; i < 2; ++i) { const bool up = (fr & 2) != 0; const float send = up ? v[i] : v[2 + i], keep = up ? v[2 + i] : v[i]; v[i] = keep + SWZX(send, 0x081F); }
        const float sre = v[0] + SWZX(v[0], 0x041F), sim = v[1] + SWZX(v[1], 0x041F);
        const int j = fr >> 1, p = 8 * (4 * half + (j >> 1)) + 2 * fq + (j & 1);
        if ((fr & 1) == 0) *(GAS f32x2*)(LOC + ((size_t)pc * 8192 + g * SP + p) * 2) = (f32x2){sre, sim};
    }
}
#ifndef REPU_RETS
#define REPU_RETS 0
#endif
#ifndef REPU_LRU0
#define REPU_LRU0 0
#endif
#ifndef REPU_RSCAN
#define REPU_RSCAN 0
#endif
#ifndef REP_P0
#define REP_P0 0
#endif
#ifndef REP_G1
#define REP_G1 0
#endif
#ifndef REP_MIXA
#define REP_MIXA 0
#endif
#ifndef REP_MIXC
#define REP_MIXC 0
#endif
#ifndef REP_S5A
#define REP_S5A 0
#endif
#ifndef REP_S5C
#define REP_S5C 0
#endif
#ifndef REP_G4
#define REP_G4 0
#endif
#ifndef REP_RMS
#define REP_RMS 0
#endif
#ifdef SKIP_P0
#define DO_P0 0
#else
#define DO_P0 1
#endif
#ifdef SKIP_RETA
#define DO_RETA 0
#else
#define DO_RETA 1
#endif
#ifdef SKIP_LRU0
#define DO_LRU0 0
#else
#define DO_LRU0 1
#endif
#ifdef SKIP_RETS
#define DO_RETS 0
#else
#define DO_RETS 1
#endif
#ifdef SKIP_LRU2
#define DO_LRU2 0
#else
#define DO_LRU2 1
#endif
#ifdef SKIP_BPH
#define DO_BPH 0
#else
#define DO_BPH 1
#endif
#ifdef SKIP_RETC
#define DO_RETC 0
#else
#define DO_RETC 1
#endif
#ifdef SKIP_LRU1
#define DO_LRU1 0
#else
#define DO_LRU1 1
#endif
#ifdef SKIP_S50
#define DO_S50 0
#else
#define DO_S50 1
#endif
#ifdef SKIP_S52
#define DO_S52 0
#else
#define DO_S52 1
#endif
#ifdef SKIP_S51
#define DO_S51 0
#else
#define DO_S51 1
#endif
#ifdef SKIP_S5B
#define DO_S5B 0
#else
#define DO_S5B 1
#endif
#ifdef SKIP_G1
#define DO_G1 0
#else
#define DO_G1 1
#endif
#ifdef SKIP_G2
#define DO_G2 0
#else
#define DO_G2 1
#endif
#ifdef SKIP_G3
#define DO_G3 0
#else
#define DO_G3 1
#endif
#ifdef SKIP_G4
#define DO_G4 0
#else
#define DO_G4 1
#endif
#ifdef SKIP_G5
#define DO_G5 0
#else
#define DO_G5 1
#endif
#ifdef SKIP_RMS
#define DO_RMS 0
#else
#define DO_RMS 1
#endif
struct Args { const float* in[N_IN]; float* out; unsigned char* ws; int ph_lo, ph_hi; };
static_assert(sizeof(Args) == (N_IN + 2) * 8 + 8, "Args has no padding");

__global__ void __launch_bounds__(NTHR, 2) fwd_kernel(Args args) {
    extern __shared__ __attribute__((aligned(16))) unsigned char lds_raw[];
    Frame F;
    F.lds = (LAS unsigned char*)lds_raw;
    F.tid = threadIdx.x; F.lane = F.tid & 63; F.wave = __builtin_amdgcn_readfirstlane(F.tid >> 6);
    F.G = gridDim.x; F.bid = blockIdx.x;
    F.out = (GAS float*)args.out; F.ws = (GAS unsigned char*)args.ws;
    volatile LAS unsigned* MISC = (volatile LAS unsigned*)(F.lds + MISC_OFF);
    for (int u = F.tid; u < (LDS_BYTES - MISC_OFF) / 4; u += NTHR) MISC[u] = 0u;
    __syncthreads();
    const int lo = args.ph_lo, hi = args.ph_hi;
    unsigned* barw = (unsigned*)(F.ws + WS_CTL) + CW_BAR;
    XcdBarrier bar; bar.bar = barw; bar.x = 0; bar.st = nullptr;
    if (hi - lo > 1) bar = xcd_barrier_post(barw, MISC + 8);
#define IN(k) (lo <= (k) && (k) < hi)
#ifndef REP_BAR
#define REP_BAR 0
#endif
#define SEAM(k) do { if (IN(k) && IN((k) + 1)) { for (int rb = 0; rb <= REP_BAR; ++rb) xcd_barrier(bar, F.tid); } } while (0)
#define LAUNDER() do { asm volatile("" : "+s"(F.ws), "+s"(F.out), "+s"(F.bid), "+v"(F.tid), "+v"(F.lane)); F.wave = __builtin_amdgcn_readfirstlane(F.tid >> 6); } while (0)
    const int gw = F.bid * NWAVES + F.wave, NGW = F.G * NWAVES;

    if (DO_P0 && IN(0)) { for (int rep = 0; rep <= REP_P0; ++rep) { LAUNDER(); p0_prologue(F); } }

    SEAM(0);

#pragma unroll 1
    for (int layer = 0; layer < 4; ++layer) {
        const int base = 1 + 9 * layer, el = layer >> 1;
        if (!(layer & 1)) {
            if (IN(base + 0)) { LAUNDER();
                pg8::Gemm g{(const GAS bf16*)(F.ws + WS_XN), (const GAS bf16*)(F.ws + WS_WIN + el * SZ_WIN), M, INW, D}; pg8::StaticOrder S; S.init(M, INW, F.G, F.bid, D / 64);
                pg8::EpiStoreBf16 E{(GAS bf16*)(F.ws + WS_PROJ), INW};

                for (int rep = 0; rep <= REP_G1; ++rep) { if (DO_G1) pg8::gemm_phase<pg8::EpiStoreBf16, pg8::StaticOrder, true, true>(F.lds, g, S, E, F.tid); }
                LAUNDER(); if (el == 0) conv_in_tail(F, CV_E0, CV_E3, (M / 256) * (INW / 256) - 3 * F.G); else conv_in_tail(F, CV_E7, CV_E10, (M / 256) * (INW / 256) - 3 * F.G);

            }
            SEAM(base + 0);
            if (IN(base + 1)) for (int rep = 0; rep <= REP_MIXA; ++rep) { LAUNDER();
#pragma unroll 1
                for (int st = 0; st < 2; ++st) {
                    LAUNDER();
                    if ((st ^ (F.bid & 1)) == 0) {
                        if (DO_RETA)
#pragma unroll 1
                        for (int rp = 0; rp <= REPU_RSCAN; ++rp) for (int u0 = F.bid; u0 < 256; u0 += F.G) { const int u = ((u0 & 7) << 5) | (u0 >> 3); ret_scan_unit(F, el, u >> 6, (u >> 4) & 3, (u >> 2) & 3, u & 3); }
                        LAUNDER();
                        if (DO_LRU0)
#pragma unroll 1
                        for (int rp = 0; rp <= REPU_LRU0; ++rp) for (int u = F.bid; u < 512; u += F.G) lru_unit<0>(F, el, u >> 7, (u >> 3) & 15, u & 7, u == F.bid || (F.G & 7) != 0);
                    } else {
                        if (DO_RETS)
#pragma unroll 1
                        for (int rp = 0; rp <= REPU_RETS; ++rp) for (int u = F.bid; u < 512; u += F.G) ret_s_unit(F, el, u >> 2, u & 3);
                        LAUNDER();
                        if (DO_LRU2)
#pragma unroll 1
                        for (int u = F.bid; u < 32; u += F.G) lru_unit<2>(F, el, 0, u >> 3, u & 7, true);
                    }
                }
            }
            SEAM(base + 1);

            if (IN(base + 3)) for (int rep = 0; rep <= REP_MIXC; ++rep) { LAUNDER();
                LAUNDER();
                if (DO_RETC)
#pragma unroll 1
                for (int u = F.bid; u < 256; u += F.G) ret_c_unit(F, u >> 6, (u >> 4) & 3, u & 15);

                LAUNDER();

                if (DO_LRU1)
#pragma unroll 1
                for (int u = F.bid; u < 512; u += F.G) lru_unit<1>(F, el, u >> 7, (u >> 3) & 15, u & 7, u == F.bid || (F.G & 7) != 0);

            }
            SEAM(base + 3);
            if (IN(base + 4)) { LAUNDER();
                pg8::Gemm g{(const GAS bf16*)(F.ws + WS_CAT), (const GAS bf16*)(F.ws + WS_WOUT + el * SZ_WOUT), M, D, D}; pg8::TailOrder S; S.init(MP, MS / 256, D, F.G, F.bid, D / 64, S_OUT);
                pg8::EpiResid E{(GAS float*)(F.ws + WS_X), D, (GAS float*)(F.ws + WS_SLAB), MP, MS};

            if (DO_G2) pg8::gemm_phase<pg8::EpiResid, pg8::TailOrder, true, true>(F.lds, g, S, E, F.tid);
            LAUNDER(); if (el == 0) conv_in_tail(F, CV_E3, CV_T2E, (MS / 256) * (D / 256) * S_OUT); else conv_in_tail(F, CV_E10, CV_T7E, (MS / 256) * (D / 256) * S_OUT);
#ifdef REP_G2
            { pg8::EpiResid E2{(GAS float*)(F.ws + WS_PROJ), D, (GAS float*)(F.ws + WS_SLAB), MP, MS}; for (int rep = 0; rep < REP_G2; ++rep) pg8::gemm_phase<pg8::EpiResid, pg8::TailOrder, true, true>(F.lds, g, S, E2, F.tid); }
#endif

            }
            SEAM(base + 4);
        } else {
            if (IN(base + 1)) for (int rep = 0; rep <= REP_S5A; ++rep) { LAUNDER();
                LAUNDER();
                if (DO_S50)
#pragma unroll 1
                for (int wu = gw; wu < 2048; wu += NGW) s5_end_units(F, el, wu & 127, (wu >> 7) & 1, wu >> 8, 8);

                LAUNDER();

                if (DO_S52)
#pragma unroll 1
                for (int u = gw; u < 32 * SG; u += NGW) s5_wave_unit<2>(F, el, 0, u >> 7, u & 127);

            }
            SEAM(base + 1);
            if (IN(base + 3)) for (int rep = 0; rep <= REP_S5C; ++rep) { LAUNDER();
                LAUNDER();
                if (DO_S51)
#pragma unroll 1
                for (int u = gw; u < BATCH * NCH * SG; u += NGW) s5_wave_unit<1>(F, el, u >> 11, (u >> 7) & 15, u & 127);

            }
            SEAM(base + 3);
            if (IN(base + 4)) { LAUNDER();
                pg8::Gemm g{(const GAS bf16*)(F.ws + WS_CAT), (const GAS bf16*)(F.ws + WS_WGLU + el * SZ_WGLU), M, 2 * D, D}; pg8::TailOrder S; S.init(MP, MS / 256, 2 * D, F.G, F.bid, D / 64, S_GLU);
                pg8::EpiGluResid E{(GAS float*)(F.ws + WS_X), D, F.inp(I_BGLU) + (size_t)el * 2 * D, D, (GAS float*)(F.ws + WS_SLAB), MP, MS};

                if (DO_G3) pg8::gemm_phase<pg8::EpiGluResid, pg8::TailOrder, true, true>(F.lds, g, S, E, F.tid);

            }
            SEAM(base + 4);
        }
        if (DO_RMS && IN(base + 5)) { LAUNDER(); if (layer & 1) rms_phase(F, 0, nullptr, 2, S_GLU, F.inp(I_BGLU) + (size_t)el * 2 * D); else rms_phase(F, 0, nullptr, 1, S_OUT, nullptr); }
        SEAM(base + 5);
        if (IN(base + 6)) { LAUNDER();
            pg8::Gemm g{(const GAS bf16*)(F.ws + WS_XN), (const GAS bf16*)(F.ws + WS_WGU + layer * SZ_WGU), M, 2 * FF, D}; pg8::StaticOrder S; S.init(M, 2 * FF, F.G, F.bid, D / 64);
            pg8::EpiSwiglu E{(GAS bf16*)(F.ws + WS_H), FF};

            for (int rep = 0; rep <= REP_G4; ++rep) { if (DO_G4) pg8::gemm_phase<pg8::EpiSwiglu, pg8::StaticOrder, true, true>(F.lds, g, S, E, F.tid); }
            LAUNDER(); { const int nb = (M / 256) * (2 * FF / 256) - 5 * F.G;
              if (layer == 0) conv_in_tail(F, CV_T2E, CV_T3E, nb); else if (layer == 1) conv_in_tail(F, CV_E6, CV_T5E, nb); else if (layer == 2) conv_in_tail(F, CV_T7E, CV_T8E, nb); }

        }
        SEAM(base + 6);
        if (IN(base + 7)) { LAUNDER();
            pg8::Gemm g{(const GAS bf16*)(F.ws + WS_H), (const GAS bf16*)(F.ws + WS_WDN + layer * SZ_WDN), M, D, FF}; pg8::TailOrder S; S.init(MP, MS / 256, D, F.G, F.bid, FF / 64, S_DN);
            pg8::EpiResid E{(GAS float*)(F.ws + WS_X), D, (GAS float*)(F.ws + WS_SLAB), MP, MS};

            if (DO_G5) pg8::gemm_phase<pg8::EpiResid, pg8::TailOrder, true, true>(F.lds, g, S, E, F.tid);
            LAUNDER(); { const int nb = (MS / 256) * (D / 256) * S_DN;
              if (layer == 0) conv_in_tail(F, CV_T3E, CV_T4E, nb); else if (layer == 1) conv_in_tail(F, CV_T5E, CV_E7, nb); else if (layer == 2) conv_in_tail(F, CV_T8E, CV_T9E, nb); }
#ifdef REP_G5
            { pg8::EpiResid E2{(GAS float*)(F.ws + WS_PROJ), D, (GAS float*)(F.ws + WS_SLAB), MP, MS}; for (int rep = 0; rep < REP_G5; ++rep) pg8::gemm_phase<pg8::EpiResid, pg8::TailOrder, true, true>(F.lds, g, S, E2, F.tid); }
#endif

        }
        SEAM(base + 7);
        if (DO_RMS && IN(base + 8)) { LAUNDER();
            if (layer == 3) { rms_phase(F, 2, F.inp(I_NFIN), 1, S_DN, nullptr); }
            else if (!(layer & 1)) { rms_phase(F, 1, F.inp(I_NMO) + (size_t)el * D, 1, S_DN, nullptr); }
            else { rms_phase(F, 0, nullptr, 1, S_DN, nullptr); }
        }
        if (layer < 3) SEAM(base + 8);
    }
#undef IN
#undef SEAM
#undef LAUNDER
}

extern "C" void kernel_launch(void* const* d_in, const int* in_sizes, int n_in, void* d_out, int out_size, void* d_ws, size_t ws_size, hipStream_t stream) {
    static int grid = 0;
    if (grid == 0) {
        if (n_in != N_IN || (size_t)out_size != O_END || ws_size < WS_END) { fprintf(stderr, "kernel_launch: unexpected sizes: n_in %d out %d ws %zu (need %d, %zu, >= %zu)\n", n_in, out_size, ws_size, (int)N_IN, (size_t)O_END, (size_t)WS_END); grid = -1; return; }
        int dev = 0, cus = 0, per_cu = 0;
        if (hipGetDevice(&dev) != hipSuccess || hipDeviceGetAttribute(&cus, hipDeviceAttributeMultiprocessorCount, dev) != hipSuccess) { grid = -1; return; }
        if (hipFuncSetAttribute((const void*)fwd_kernel, hipFuncAttributeMaxDynamicSharedMemorySize, LDS_BYTES) != hipSuccess) { fprintf(stderr, "kernel_launch: hipFuncSetAttribute failed\n"); grid = -1; return; }
        if (hipOccupancyMaxActiveBlocksPerMultiprocessor(&per_cu, (const void*)fwd_kernel, NTHR, LDS_BYTES) != hipSuccess || per_cu < 1) { fprintf(stderr, "kernel_launch: occupancy query says %d blocks per CU\n", per_cu); (void)hipGetLastError(); grid = -1; return; }
        grid = cus;
    }
    if (grid < 0) return;
    if (hipMemsetAsync((char*)d_ws + WS_CTL, 0, CTL_ZERO_BYTES, stream) != hipSuccess) return;
    Args a{};
    for (int i = 0; i < N_IN; ++i) a.in[i] = (const float*)d_in[i];
    a.out = (float*)d_out; a.ws = (unsigned char*)d_ws;
#if MK_ONE_LAUNCH
    a.ph_lo = 0; a.ph_hi = NPHASE;
    hipLaunchKernelGGL(fwd_kernel, dim3(grid), dim3(NTHR), LDS_BYTES, stream, a);
#else
    for (int ph = 0; ph < NPHASE; ++ph) {
        if (ph >= 1 && ((ph - 1) % 9) == 0 && (((ph - 1) / 9) & 1)) continue;
        if (ph >= 1 && ((ph - 1) % 9) == 2) continue;
        a.ph_lo = ph; a.ph_hi = ph + 1;
        hipLaunchKernelGGL(fwd_kernel, dim3(grid), dim3(NTHR), LDS_BYTES, stream, a);
    }
#endif
}
```

```cpp
#include <hip/hip_runtime.h>
#include <cstdio>
#include <cstdint>
#define MK_ONE_LAUNCH 1
namespace pg8 {
#define PG8_LAS __attribute__((address_space(3)))
#define PG8_GAS __attribute__((address_space(1)))
typedef unsigned short __attribute__((may_alias)) bf16_t;
typedef short bf16x8 __attribute__((ext_vector_type(8), may_alias));
typedef float f32x4 __attribute__((ext_vector_type(4), may_alias));
typedef unsigned u32x4 __attribute__((ext_vector_type(4), may_alias));
constexpr int BM = 256, BK = 64, HALF = 128, HTB = HALF * BK * 2  , STAGE_BYTES = 8 * HTB, NXCD = 8, WGM = 8;

__host__ __device__ __forceinline__ int lds_byte(int r, int c) { const int st = (r >> 4) * 2 + (c >> 5), rr = r & 15, cc = c & 31, ob = rr * 64 + cc * 2; return st * 1024 + (ob ^ (((ob >> 9) & 1) << 5)); }
__host__ __device__ __forceinline__ void stage_rc(int b, int& R, int& C) { const int st = b / 1024, sb = b % 1024, swz = sb ^ (((sb >> 9) & 1) << 5); R = (st >> 1) * 16 + swz / 64; C = (st & 1) * 32 + (swz % 64) / 2; }
__host__ __device__ __forceinline__ int perm32(int rho) { const int n = rho >> 4, i = rho & 15; return 8 * (i >> 2) + 4 * n + (i & 3); }

struct Unit { int pm, pn, k0, nt, slice; };
struct Gemm { const PG8_GAS bf16_t* A; const PG8_GAS bf16_t* Bt; int M, N, K; };

struct StaticOrder {
    int nM, nN, nwg, G, c, ntk;
    __host__ __device__ void init(int M, int N, int G_, int c_, int ntk_) { nM = M / BM; nN = N / BM; nwg = nM * nN; G = G_; c = c_; ntk = ntk_; }
    __host__ __device__ bool next(int i, Unit& u) const {
        const long L = (long)i * G + c; if (L >= nwg) return false;
        int wgid = (int)L; { const int q = nwg / NXCD, r = nwg % NXCD, xcd = wgid % NXCD, off = wgid / NXCD; wgid = (xcd < r ? xcd * (q + 1) : r * (q + 1) + (xcd - r) * q) + off; }
        const int nig = WGM * nN, gid = wgid / nig, fm = gid * WGM, gsz = (nM - fm) < WGM ? (nM - fm) : WGM;
        u.pm = fm + ((wgid % nig) % gsz); u.pn = (wgid % nig) / gsz; u.k0 = 0; u.nt = ntk; u.slice = -1; return true;
    }
    __device__ __forceinline__ void a_ready(const Unit&) const {}
    __device__ __forceinline__ void done(const Unit&) const {}
};

struct TailOrder {
    StaticOrder main; int nN, S, nts, ntail, pm0;
    __host__ __device__ void init(int Mmain, int ntail_m, int N, int G_, int c_, int ntk, int S_) { main.init(Mmain, N, G_, c_, ntk); nN = N / BM; S = S_; nts = ntk / S_; ntail = ntail_m * nN * S_; pm0 = Mmain / BM; }
    __host__ __device__ bool next(int i, Unit& u) const {
        const long L = (long)i * main.G + main.c;
        if (L < main.nwg) return main.next(i, u);
        const int j = (int)(L - main.nwg); if (j >= ntail) return false;
        const int tile = j / S, sl = j - tile * S;
        u.pm = pm0 + (tile & 1); u.pn = tile >> 1; u.k0 = sl * nts * BK; u.nt = nts; u.slice = sl; return true;
    }
    __device__ __forceinline__ void a_ready(const Unit&) const {}
    __device__ __forceinline__ void done(const Unit&) const {}
};
typedef __bf16 bf16v2_ __attribute__((ext_vector_type(2))); typedef float f32v2_ __attribute__((ext_vector_type(2)));
__device__ __forceinline__ unsigned cvt_pk_bf16(float lo, float hi) { const f32v2_ v = {lo, hi}; return __builtin_bit_cast(unsigned, __builtin_convertvector(v, bf16v2_)); }
typedef float f32x2 __attribute__((ext_vector_type(2)));
__device__ __forceinline__ float fast_sigmoid(float x) { return __builtin_amdgcn_rcpf(1.0f + __builtin_amdgcn_exp2f(-1.44269504f * x)); }
struct EpiStoreBf16 {
    static constexpr bool PERM = true, AFTER_DRAIN = false;
    PG8_GAS bf16_t* O; int ldc;
    __device__ __forceinline__ void operator()(const f32x4 (&acc)[2][2][4][2], const Unit& u, int wr, int wc, int fr, int fq) const {
        const int row0 = u.pm * BM + wr * 64 + fr, col0 = u.pn * BM + wc * 32 + 8 * fq;
#pragma unroll
        for (int ai = 0; ai < 2; ++ai)
#pragma unroll
            for (int m = 0; m < 4; ++m) { PG8_GAS bf16_t* rowp = O + (size_t)(row0 + ai * HALF + m * 16) * ldc + col0;
#pragma unroll
                for (int bj = 0; bj < 2; ++bj) { const f32x4 v0 = acc[ai][bj][m][0], v1 = acc[ai][bj][m][1];
                    u32x4 w; w.x = cvt_pk_bf16(v0[0], v0[1]); w.y = cvt_pk_bf16(v0[2], v0[3]); w.z = cvt_pk_bf16(v1[0], v1[1]); w.w = cvt_pk_bf16(v1[2], v1[3]);
                    *(PG8_GAS u32x4*)(rowp + bj * HALF) = w; } }
    }
};
struct EpiResid {
    static constexpr bool PERM = false, AFTER_DRAIN = false;
    PG8_GAS float* X; int ldc; PG8_GAS float* slab; int row_base, slab_rows;
    __device__ __forceinline__ void operator()(const f32x4 (&acc)[2][2][4][2], const Unit& u, int wr, int wc, int fr, int fq) const {
        const int row0 = u.pm * BM + wr * 64 + fr, col0 = u.pn * BM + wc * 32 + 4 * fq;
        if (u.slice >= 0) {
            PG8_GAS float* sb = slab + ((size_t)u.slice * slab_rows + (row0 - row_base)) * ldc + col0;
#pragma unroll
            for (int ai = 0; ai < 2; ++ai)
#pragma unroll
                for (int m = 0; m < 4; ++m) { PG8_GAS float* rowp = sb + (size_t)(ai * HALF + m * 16) * ldc;
#pragma unroll
                    for (int bj = 0; bj < 2; ++bj)
#pragma unroll
                        for (int n = 0; n < 2; ++n) *(PG8_GAS f32x4*)(rowp + bj * HALF + n * 16) = acc[ai][bj][m][n]; }
            return;
        }
#pragma unroll
        for (int ai = 0; ai < 2; ++ai)
#pragma unroll
            for (int m = 0; m < 4; ++m) { PG8_GAS float* rowp = X + (size_t)(row0 + ai * HALF + m * 16) * ldc + col0;
                f32x4 b[2][2];
#pragma unroll
                for (int bj = 0; bj < 2; ++bj)
#pragma unroll
                    for (int n = 0; n < 2; ++n) b[bj][n] = *(const PG8_GAS f32x4*)(rowp + bj * HALF + n * 16);
#pragma unroll
                for (int bj = 0; bj < 2; ++bj)
#pragma unroll
                    for (int n = 0; n < 2; ++n) *(PG8_GAS f32x4*)(rowp + bj * HALF + n * 16) = b[bj][n] + acc[ai][bj][m][n];
                if (m == 3) asm volatile("" ::: "memory"); }
    }
};
struct EpiSwiglu {
    static constexpr bool PERM = true, AFTER_DRAIN = false;
    PG8_GAS bf16_t* H; int ldh;
    __device__ __forceinline__ void operator()(const f32x4 (&acc)[2][2][4][2], const Unit& u, int wr, int wc, int fr, int fq) const {
        const int row0 = u.pm * BM + wr * 64 + fr, col0 = u.pn * HALF + wc * 32 + 8 * fq;
#pragma unroll
        for (int ai = 0; ai < 2; ++ai)
#pragma unroll
            for (int m = 0; m < 4; ++m) { PG8_GAS bf16_t* rowp = H + (size_t)(row0 + ai * HALF + m * 16) * ldh + col0;
                f32x4 v[2];
#pragma unroll
                for (int n = 0; n < 2; ++n) { const f32x4 g = acc[ai][0][m][n], uu = acc[ai][1][m][n];
#pragma unroll
                    for (int j = 0; j < 4; ++j) v[n][j] = g[j] * fast_sigmoid(g[j]) * uu[j]; }
                u32x4 w; w.x = cvt_pk_bf16(v[0][0], v[0][1]); w.y = cvt_pk_bf16(v[0][2], v[0][3]); w.z = cvt_pk_bf16(v[1][0], v[1][1]); w.w = cvt_pk_bf16(v[1][2], v[1][3]);
                *(PG8_GAS u32x4*)rowp = w; }
    }
};
struct EpiGluResid {
    static constexpr bool PERM = false, AFTER_DRAIN = false;
    PG8_GAS float* X; int ldc; const PG8_GAS float* bias; int nhalf; PG8_GAS float* slab; int row_base, slab_rows;
    __device__ __forceinline__ void operator()(const f32x4 (&acc)[2][2][4][2], const Unit& u, int wr, int wc, int fr, int fq) const {
        const int row0 = u.pm * BM + wr * 64 + fr;
        if (u.slice >= 0) {
            PG8_GAS float* sb = slab + ((size_t)u.slice * slab_rows + (row0 - row_base)) * (2 * ldc) + u.pn * BM + wc * 32 + 4 * fq;
#pragma unroll
            for (int ai = 0; ai < 2; ++ai)
#pragma unroll
                for (int m = 0; m < 4; ++m) { PG8_GAS float* rowp = sb + (size_t)(ai * HALF + m * 16) * (2 * ldc);
#pragma unroll
                    for (int bj = 0; bj < 2; ++bj)
#pragma unroll
                        for (int n = 0; n < 2; ++n) *(PG8_GAS f32x4*)(rowp + bj * HALF + n * 16) = acc[ai][bj][m][n]; }
            return;
        }
        const int col0 = u.pn * HALF + wc * 32 + 4 * fq;
        f32x4 b1[2], b2[2];
#pragma unroll
        for (int n = 0; n < 2; ++n) { b1[n] = *(const PG8_GAS f32x4*)(bias + col0 + n * 16); b2[n] = *(const PG8_GAS f32x4*)(bias + nhalf + col0 + n * 16); }
#pragma unroll
        for (int ai = 0; ai < 2; ++ai)
#pragma unroll
            for (int m = 0; m < 4; ++m) { PG8_GAS float* rowp = X + (size_t)(row0 + ai * HALF + m * 16) * ldc + col0;
#pragma unroll
                for (int n = 0; n < 2; ++n) { const f32x4 z1 = acc[ai][0][m][n] + b1[n], z2 = acc[ai][1][m][n] + b2[n]; f32x4 o = *(const PG8_GAS f32x4*)(rowp + n * 16);
#pragma unroll
                    for (int j = 0; j < 4; ++j) o[j] += z1[j] * fast_sigmoid(z2[j]);
                    *(PG8_GAS f32x4*)(rowp + n * 16) = o; }
                if (m == 3) asm volatile("" ::: "memory"); }
    }
};
template <class Epi, class Sched, bool ALIGN_EPI = false, bool SP2 = false>
__device__ __forceinline__ void gemm_phase(PG8_LAS unsigned char* lds, const Gemm g, const Sched& S, const Epi& E, int tid_in) {
    int tid_ = tid_in; asm volatile("" : "+v"(tid_));
    const int tid = tid_, wid = __builtin_amdgcn_readfirstlane(tid >> 6), lane = tid & 63, wr = wid >> 2, wc = wid & 3, fr = lane & 15, fq = lane >> 4;
    const int K = g.K;
    unsigned voffA[2], voffB[2];
#pragma unroll
    for (int i = 0; i < 2; ++i) { int R, C; stage_rc(tid * 16 + i * 8192, R, C); const int Rb = Epi::PERM ? ((R & ~31) + perm32(R & 31)) : R;
        voffA[i] = (unsigned)(R * K + C) * 2u; voffB[i] = (unsigned)(Rb * K + C) * 2u; }
    const size_t kstep = (size_t)(BK * 2);
    const size_t hstep = (size_t)HALF * K * 2;
    const size_t tstep = 2 * hstep;
    const unsigned ldsw = (unsigned)wid * 1024u;
    const int aoff = lds_byte(wr * 64 + fr, fq * 8), boff = lds_byte(wc * 32 + fr, fq * 8);
#define PG8_SA(b, h) (((b) * 2 + (h)) * HTB)
#define PG8_SB(b, h) ((4 + (b) * 2 + (h)) * HTB)
#define PG8_STAGE(bufoff, gbase, voff) do { _Pragma("unroll") for (int _i = 0; _i < 2; ++_i) \
        __builtin_amdgcn_global_load_lds((const PG8_GAS unsigned*)((const PG8_GAS char*)(gbase) + (voff)[_i]), (PG8_LAS unsigned*)(lds + (bufoff) + ldsw + _i * 8192), 16, 0, 0); } while (0)
#define PG8_LDA(dst, b, h) do { _Pragma("unroll") for (int m = 0; m < 4; ++m) _Pragma("unroll") for (int k = 0; k < 2; ++k) dst[m][k] = *(const PG8_LAS bf16x8*)(lds + PG8_SA(b, h) + aoff + m * 2048 + k * 1024); } while (0)
#define PG8_LDB(dst, b, h) do { _Pragma("unroll") for (int n = 0; n < 2; ++n) _Pragma("unroll") for (int k = 0; k < 2; ++k) dst[n][k] = *(const PG8_LAS bf16x8*)(lds + PG8_SB(b, h) + boff + n * 2048 + k * 1024); } while (0)
#define PG8_MMA(ai, bj, At, Bt) do { __builtin_amdgcn_s_setprio(1); _Pragma("unroll") for (int m = 0; m < 4; ++m) _Pragma("unroll") for (int n = 0; n < 2; ++n) _Pragma("unroll") for (int k = 0; k < 2; ++k) \
        acc[ai][bj][m][n] = __builtin_amdgcn_mfma_f32_16x16x32_bf16(Bt[n][k], At[m][k], acc[ai][bj][m][n], 0, 0, 0); __builtin_amdgcn_s_setprio(0); } while (0)
#define PG8_WAIT_V(n) asm volatile("s_waitcnt vmcnt(" #n ")" ::: "memory")
#define PG8_WAIT_L(n) asm volatile("s_waitcnt lgkmcnt(" #n ")" ::: "memory")
#define PG8_BAR __builtin_amdgcn_s_barrier()
#define PG8_SCHED __builtin_amdgcn_sched_barrier(0)
    Unit cur, nxt; int ui = 0;
    if (!S.next(0, cur)) return;
    f32x4 acc[2][2][4][2];
#pragma unroll
    for (int a = 0; a < 2; ++a)
#pragma unroll
        for (int b = 0; b < 2; ++b)
#pragma unroll
            for (int m = 0; m < 4; ++m)
#pragma unroll
                for (int n = 0; n < 2; ++n) acc[a][b][m][n] = (f32x4){0.f, 0.f, 0.f, 0.f};
    bf16x8 At[4][2], B0[2][2], B1[2][2];
    const PG8_GAS char* cA = (const PG8_GAS char*)g.A + (size_t)cur.pm * tstep + (size_t)cur.k0 * 2; const PG8_GAS char* cB = (const PG8_GAS char*)g.Bt + (size_t)cur.pn * tstep + (size_t)cur.k0 * 2;
    S.a_ready(cur);
    if constexpr (SP2) {
        PG8_STAGE(PG8_SB(0, 0), cB, voffB); PG8_STAGE(PG8_SB(0, 1), cB + hstep, voffB); PG8_STAGE(PG8_SA(0, 0), cA, voffA); PG8_STAGE(PG8_SA(0, 1), cA + hstep, voffA);
        if (wr == 1) PG8_BAR;
        PG8_WAIT_V(2); PG8_BAR;
        PG8_STAGE(PG8_SB(1, 0), cB + kstep, voffB); PG8_STAGE(PG8_SA(1, 0), cA + kstep, voffA); PG8_STAGE(PG8_SB(1, 1), cB + hstep + kstep, voffB);
        PG8_WAIT_V(6); PG8_BAR;
    } else {
        PG8_STAGE(PG8_SB(0, 0), cB, voffB); PG8_STAGE(PG8_SA(0, 0), cA, voffA); PG8_STAGE(PG8_SB(0, 1), cB + hstep, voffB); PG8_STAGE(PG8_SA(0, 1), cA + hstep, voffA);
        if (wr == 1) PG8_BAR;
        PG8_WAIT_V(4); PG8_BAR;
        PG8_STAGE(PG8_SB(1, 0), cB + kstep, voffB); PG8_STAGE(PG8_SA(1, 0), cA + kstep, voffA); PG8_STAGE(PG8_SB(1, 1), cB + hstep + kstep, voffB);
        PG8_WAIT_V(6); PG8_BAR;
    }
    for (;;) {
        const bool has_next = S.next(ui + 1, nxt);
        const PG8_GAS char* nA = has_next ? (const PG8_GAS char*)g.A + (size_t)nxt.pm * tstep + (size_t)nxt.k0 * 2 : cA; const PG8_GAS char* nB = has_next ? (const PG8_GAS char*)g.Bt + (size_t)nxt.pn * tstep + (size_t)nxt.k0 * 2 : cB;
        const int nt = cur.nt;
        for (int t = 0; t < nt; t += 2) {
            const bool last = (t == nt - 2);
            const PG8_GAS char* a1 = cA + (size_t)(t + 1) * kstep;
            const PG8_GAS char* a2 = last ? nA : cA + (size_t)(t + 2) * kstep; const PG8_GAS char* b2 = last ? nB : cB + (size_t)(t + 2) * kstep;
            const PG8_GAS char* a3 = a2 + kstep; const PG8_GAS char* b3 = b2 + kstep;
            if (last && has_next) S.a_ready(nxt);
            if constexpr (SP2) {
            PG8_LDB(B0, 0, 0); PG8_LDB(B1, 0, 1); PG8_SCHED; PG8_LDA(At, 0, 0); PG8_STAGE(PG8_SA(1, 1), a1 + hstep, voffA);
            PG8_WAIT_V(8); PG8_WAIT_L(0); PG8_BAR; PG8_MMA(0, 0, At, B0); PG8_MMA(0, 1, At, B1); PG8_BAR; PG8_SCHED;
            PG8_LDA(At, 0, 1); PG8_STAGE(PG8_SB(0, 0), b2, voffB); PG8_STAGE(PG8_SB(0, 1), b2 + hstep, voffB); PG8_STAGE(PG8_SA(0, 0), a2, voffA);
            PG8_WAIT_V(8); PG8_WAIT_L(0); PG8_BAR; PG8_MMA(1, 0, At, B0); PG8_MMA(1, 1, At, B1); PG8_BAR; PG8_SCHED;
            PG8_LDB(B0, 1, 0); PG8_LDB(B1, 1, 1); PG8_SCHED; PG8_LDA(At, 1, 0); PG8_STAGE(PG8_SA(0, 1), a2 + hstep, voffA);
            PG8_WAIT_V(8); PG8_WAIT_L(0); PG8_BAR; PG8_MMA(0, 0, At, B0); PG8_MMA(0, 1, At, B1); PG8_BAR; PG8_SCHED;
            PG8_LDA(At, 1, 1); PG8_STAGE(PG8_SB(1, 0), b3, voffB); PG8_STAGE(PG8_SB(1, 1), b3 + hstep, voffB); PG8_STAGE(PG8_SA(1, 0), a3, voffA);
            PG8_WAIT_V(8); PG8_WAIT_L(0); PG8_BAR; PG8_MMA(1, 0, At, B0); PG8_MMA(1, 1, At, B1); PG8_BAR; PG8_SCHED;
            } else {
            PG8_LDB(B0, 0, 0); PG8_SCHED; PG8_LDA(At, 0, 0); PG8_STAGE(PG8_SA(1, 1), a1 + hstep, voffA);
            PG8_WAIT_L(8); PG8_BAR; PG8_WAIT_L(0); PG8_MMA(0, 0, At, B0); PG8_BAR; PG8_SCHED;
            PG8_LDB(B1, 0, 1); PG8_STAGE(PG8_SB(0, 0), b2, voffB);
            PG8_BAR; PG8_WAIT_L(0); PG8_MMA(0, 1, At, B1); PG8_BAR;
            PG8_LDA(At, 0, 1); PG8_STAGE(PG8_SA(0, 0), a2, voffA);
            PG8_BAR; PG8_WAIT_L(0); PG8_MMA(1, 0, At, B0); PG8_BAR; PG8_SCHED;
            PG8_STAGE(PG8_SB(0, 1), b2 + hstep, voffB);
            PG8_WAIT_V(6); PG8_BAR; PG8_MMA(1, 1, At, B1); PG8_BAR;
            PG8_LDB(B0, 1, 0); PG8_SCHED; PG8_LDA(At, 1, 0); PG8_STAGE(PG8_SA(0, 1), a2 + hstep, voffA);
            PG8_WAIT_L(8); PG8_BAR; PG8_WAIT_L(0); PG8_MMA(0, 0, At, B0); PG8_BAR; PG8_SCHED;
            PG8_LDB(B1, 1, 1); PG8_STAGE(PG8_SB(1, 0), b3, voffB);
            PG8_BAR; PG8_WAIT_L(0); PG8_MMA(0, 1, At, B1); PG8_BAR;
            PG8_LDA(At, 1, 1); PG8_STAGE(PG8_SA(1, 0), a3, voffA);
            PG8_BAR; PG8_WAIT_L(0); PG8_MMA(1, 0, At, B0); PG8_BAR; PG8_SCHED;
            PG8_STAGE(PG8_SB(1, 1), b3 + hstep, voffB);
            PG8_WAIT_V(6); PG8_BAR; PG8_MMA(1, 1, At, B1); PG8_BAR;
            }
        }
        if constexpr (ALIGN_EPI) { if (wr == 0) PG8_BAR; }
        if constexpr (!Epi::AFTER_DRAIN) { E(acc, cur, wr, wc, fr, fq); S.done(cur); }
        if (!has_next) break;
#pragma unroll
        for (int a = 0; a < 2; ++a)
#pragma unroll
            for (int b = 0; b < 2; ++b)
#pragma unroll
                for (int m = 0; m < 4; ++m)
#pragma unroll
                    for (int n = 0; n < 2; ++n) acc[a][b][m][n] = (f32x4){0.f, 0.f, 0.f, 0.f};
        cur = nxt; cA = nA; cB = nB; ++ui;
        if constexpr (ALIGN_EPI) { if (wr == 1) PG8_BAR; }
    }
    PG8_WAIT_V(0);
    if constexpr (!ALIGN_EPI) { if (wr == 0) PG8_BAR; }
    PG8_BAR;
    if constexpr (Epi::AFTER_DRAIN) { E.fused(acc, cur, wr, wc, fr, fq, lds, wid, lane); S.done(cur); }
#undef PG8_SA
#undef PG8_SB
#undef PG8_STAGE
#undef PG8_LDA
#undef PG8_LDB
#undef PG8_MMA
#undef PG8_WAIT_V
#undef PG8_WAIT_L
#undef PG8_BAR
#undef PG8_SCHED
}
}
constexpr int NWAVES = 8, NTHR = 512;
constexpr int D = 2048, BATCH = 4, SEQ = 2048, DEC_B = 128, DEC_T = 4, PAST = 16384;
constexpr int MP = BATCH * SEQ;
constexpr int MS = DEC_B * DEC_T;
constexpr int M = MP + MS;
constexpr int HALFW = 1024, RH = 4, DK = 256, LRU_W = 1024, LRU_H = 8, LRU_BLK = 128, INW = 6144;
constexpr int SG = 128, SP = 64, FF = 5632, NCH = 16, CH = 128;
constexpr float EPS = 1e-6f;
constexpr int NPOS = SEQ + DEC_T;

enum { I_XP = 0, I_XS, I_SRET, I_SLRU, I_SCONV, I_SSRE, I_SSIM, I_NME, I_WIN, I_CW, I_CB, I_WA, I_BA, I_WX, I_BX, I_LAM, I_WOUT, I_NMO, I_ARE, I_AIM,
       I_BRE, I_BIM, I_CRE, I_CIM, I_SD, I_LDT, I_WGLU, I_BGLU, I_NF, I_WGU, I_WDN, I_NFIN, N_IN };

constexpr size_t O_YP = 0, O_YS = O_YP + (size_t)MP * D, O_RETP = O_YS + (size_t)MS * D, O_RETS = O_RETP + (size_t)2 * BATCH * RH * DK * DK,
                 O_LRUP = O_RETS + (size_t)2 * DEC_B * RH * DK * DK, O_LRUS = O_LRUP + (size_t)2 * BATCH * LRU_W, O_CONVP = O_LRUS + (size_t)2 * DEC_B * LRU_W,
                 O_CONVS = O_CONVP + (size_t)2 * BATCH * 3 * LRU_W, O_SREP = O_CONVS + (size_t)2 * DEC_B * 3 * LRU_W, O_SRES = O_SREP + (size_t)2 * BATCH * SG * SP,
                 O_SIMP = O_SRES + (size_t)2 * DEC_B * SG * SP, O_SIMS = O_SIMP + (size_t)2 * BATCH * SG * SP, O_END = O_SIMS + (size_t)2 * DEC_B * SG * SP;

constexpr size_t al256(size_t x) { return (x + 255) & ~(size_t)255; }
constexpr size_t WS_CTL = 0, CTL_BYTES = 1u << 20, CTL_ZERO_BYTES = 32768;
constexpr size_t SZ_WIN = (size_t)INW * D * 2, SZ_WOUT = (size_t)D * D * 2, SZ_WGLU = (size_t)2 * D * D * 2, SZ_WGU = (size_t)2 * FF * D * 2, SZ_WDN = (size_t)D * FF * 2;
constexpr size_t WS_WIN = CTL_BYTES, WS_WOUT = WS_WIN + 2 * SZ_WIN, WS_WGLU = WS_WOUT + 2 * SZ_WOUT, WS_WGU = WS_WGLU + 2 * SZ_WGLU, WS_WDN = WS_WGU + 4 * SZ_WGU;
constexpr size_t WS_X = WS_WDN + 4 * SZ_WDN;
constexpr size_t WS_XN = WS_X + (size_t)M * D * 4;
constexpr size_t WS_PROJ = WS_XN + (size_t)M * D * 2;
constexpr size_t WS_H = WS_PROJ + (size_t)M * INW * 2;
constexpr size_t WS_CAT = WS_H + (size_t)M * FF * 2;
constexpr size_t WS_UT = WS_CAT + (size_t)M * D * 2;
constexpr size_t WS_ROPE = WS_UT + (size_t)256 * 65536 * 4;
constexpr size_t WS_LRUW = al256(WS_ROPE + (size_t)2 * NPOS * 128 * 4);
constexpr size_t WS_LRUC = WS_LRUW + (size_t)2 * 8 * 256 * 128 * 2;
constexpr size_t WS_LSA = WS_LRUC + (size_t)2 * 1024 * 4;
constexpr size_t WS_LSB = WS_LSA + (size_t)4 * 16 * 1024 * 4;
constexpr size_t WS_LCIN = WS_LSB + (size_t)4 * 16 * 1024 * 4;
constexpr size_t WS_S5BB = WS_LCIN + (size_t)4 * 16 * 1024 * 4;
constexpr size_t WS_S5CM = WS_S5BB + (size_t)2 * 128 * 128 * 16 * 2;
constexpr size_t WS_S5AB = WS_S5CM + (size_t)2 * 128 * 16 * 128 * 2;
constexpr size_t WS_S5LOC = WS_S5AB + (size_t)2 * 8192 * 4 * 4;
constexpr size_t WS_SLAB = WS_S5LOC + (size_t)4 * 16 * 8192 * 2 * 4;
constexpr size_t WS_S5PW = WS_SLAB + (size_t)8 * 512 * 4096 * 4;
constexpr size_t WS_END = WS_S5PW + (size_t)2 * 128 * 8 * 8 * 64 * 8;
constexpr int S_DN = 11, S_OUT = 8, S_GLU = 8;
static_assert(WS_END < (size_t)1000 * 1000 * 1000, "workspace map must stay below the guaranteed d_ws size");
constexpr int CW_BAR = 4096;
static_assert((CW_BAR + 3456) * 4 <= (int)CTL_ZERO_BYTES, "barrier words inside the zeroed region");

constexpr int LDS_BYTES = 147456;
constexpr int MISC_OFF = 146944;
constexpr int PH_LDS = 146944;

constexpr int NPHASE = 1 + 9 * 4;
#ifndef MK_ONE_LAUNCH
#define MK_ONE_LAUNCH 0
#endif
#define GAS __attribute__((address_space(1)))
#define LAS __attribute__((address_space(3)))
typedef unsigned short __attribute__((may_alias)) bf16;
typedef unsigned v4u __attribute__((ext_vector_type(4), may_alias));
typedef unsigned v2u __attribute__((ext_vector_type(2), may_alias));
typedef float f32x4 __attribute__((ext_vector_type(4), may_alias));
typedef float f32x2 __attribute__((ext_vector_type(2), may_alias));
typedef short bf16x8 __attribute__((ext_vector_type(8), may_alias));
typedef short bf16x4 __attribute__((ext_vector_type(4), may_alias));
typedef unsigned __attribute__((may_alias)) u32a;
typedef float __attribute__((may_alias)) f32a;
#define LDS_WAIT() asm volatile("s_waitcnt lgkmcnt(0)" ::: "memory")
#define VM_WAIT() asm volatile("s_waitcnt vmcnt(0)" ::: "memory")
typedef __bf16 bf16v2 __attribute__((ext_vector_type(2)));
typedef float f32v2c __attribute__((ext_vector_type(2)));
__device__ __forceinline__ unsigned pk2(float lo, float hi) { const f32v2c v = {lo, hi}; return __builtin_bit_cast(unsigned, __builtin_convertvector(v, bf16v2)); }
__device__ __forceinline__ unsigned f2bf(float f) { return pk2(f, f) & 0xffffu; }
__device__ __forceinline__ float bflo(unsigned w) { return __builtin_bit_cast(float, w << 16); }
__device__ __forceinline__ float bfhi(unsigned w) { return __builtin_bit_cast(float, w & 0xffff0000u); }
__device__ __forceinline__ float bf2f(bf16 h) { return __builtin_bit_cast(float, (unsigned)h << 16); }
__device__ __forceinline__ float wave_sum(float v) {
#pragma unroll
    for (int o = 1; o < 64; o <<= 1) v += __shfl_xor(v, o);
    return v;
}
__device__ __forceinline__ float sigmoidf_(float x) { return __builtin_amdgcn_rcpf(1.0f + __builtin_amdgcn_exp2f(-1.44269504f * x)); }
__device__ __forceinline__ float siluf_(float x) { return x * sigmoidf_(x); }
__device__ __forceinline__ float geluf_(float x) { const float u = 0.7978845608f * (x + 0.044715f * x * x * x); return x * sigmoidf_(2.0f * u); }
#define MFMA32(a, b, c) __builtin_amdgcn_mfma_f32_16x16x32_bf16((a), (b), (c), 0, 0, 0)
#define MFMA16(a, b, c) __builtin_amdgcn_mfma_f32_16x16x16bf16_1k((a), (b), (c), 0, 0, 0)
#if defined(__HIP_DEVICE_COMPILE__)
#define ASSUME_GLOBAL(p) __builtin_assume(!__builtin_amdgcn_is_shared((const __attribute__((address_space(0))) void*)(p)) && !__builtin_amdgcn_is_private((const __attribute__((address_space(0))) void*)(p)))
#else
#define ASSUME_GLOBAL(p) ((void)0)
#endif
#define XB_TMO      128
#define XB_XCNT(j)  (256  + 64 * (j))
#define XB_XSUB(j)  (1280 + 64 * (j))
#define XB_XGEN(j)  (2304 + 64 * (j))
#define XB_TOP      3328
#define XB_TOPGEN   3392
#define XCD_BAR_WORDS 3456
#define XB_SPIN_CAP (1u << 18)

__device__ __forceinline__ unsigned xb_ld(unsigned* p)              { return __hip_atomic_load(p, __ATOMIC_RELAXED, __HIP_MEMORY_SCOPE_AGENT); }
__device__ __forceinline__ unsigned xb_add(unsigned* p, unsigned v) { return __hip_atomic_fetch_add(p, v, __ATOMIC_RELAXED, __HIP_MEMORY_SCOPE_AGENT); }
__device__ __forceinline__ unsigned xb_xcc_id() { return (unsigned)__builtin_amdgcn_s_getreg((3 << 11) | 20) & 0xFu; }
#define XB_SPIN(cond, bar) do { unsigned _sp = 0; while (cond) { __builtin_amdgcn_s_sleep(1); \
    if ((++_sp & 255u) == 0u) { if (xb_ld(&(bar)[XB_TMO])) break; if (_sp > XB_SPIN_CAP) { atomicAdd(&(bar)[XB_TMO], 1u); break; } } } } while (0)

struct XcdBarrier {
    unsigned* bar; unsigned x;
    volatile LAS unsigned* st;
};

__device__ __forceinline__ XcdBarrier xcd_barrier_post(unsigned* bar, volatile LAS unsigned* st) {
    XcdBarrier b; b.bar = bar; b.x = xb_xcc_id(); b.st = st;
    if (threadIdx.x == 0) (void)xb_add(&bar[XB_XCNT(b.x)], 1u);
    return b;
}
__device__ __forceinline__ void xcd_barrier_complete(unsigned* bar, unsigned x, unsigned& nloc, unsigned& nx) {
    const unsigned G = gridDim.x * gridDim.y * gridDim.z;
    unsigned sum, cnt, mine, sp = 0u;
    for (;;) {
        sum = 0u; cnt = 0u; mine = 0u;
#pragma unroll
        for (unsigned j = 0; j < 16; ++j) { const unsigned c = xb_ld(&bar[XB_XCNT(j)]); sum += c; cnt += (c > 0u) ? 1u : 0u; mine = (j == x) ? c : mine; }
        if (sum == G) break;
        __builtin_amdgcn_s_sleep(1);
        if ((++sp & 255u) == 0u) { if (xb_ld(&bar[XB_TMO])) break; if (sp > XB_SPIN_CAP) { atomicAdd(&bar[XB_TMO], 1u); break; } }
    }
    nloc = mine > 0u ? mine : 1u; nx = cnt > 0u ? cnt : 1u;
}

__device__ __forceinline__ void xcd_barrier(const XcdBarrier& b, int tid_) {
    asm volatile("s_waitcnt vmcnt(0)" ::: "memory");
    __syncthreads();
    if (tid_ == 0) {
        unsigned* bar = b.bar;
        __builtin_amdgcn_s_waitcnt(0);
        unsigned nloc = b.st[0], nx = b.st[1];
        if (nloc == 0u) { xcd_barrier_complete(bar, b.x, nloc, nx); b.st[0] = nloc; b.st[1] = nx; }
        const unsigned old = xb_add(&bar[XB_XSUB(b.x)], 1u);
        const unsigned gen = old / nloc;
        if (old + 1u == (gen + 1u) * nloc) {
            __builtin_amdgcn_fence(__ATOMIC_RELEASE, "agent");
            asm volatile("s_waitcnt vmcnt(0)" ::: "memory");
            const unsigned og = xb_add(&bar[XB_TOP], 1u);
            const unsigned tg = og / nx;
            if (og + 1u == (tg + 1u) * nx) xb_add(&bar[XB_TOPGEN], 1u);
            else XB_SPIN(xb_ld(&bar[XB_TOPGEN]) == tg, bar);
            __builtin_amdgcn_fence(__ATOMIC_ACQUIRE, "agent");
            xb_add(&bar[XB_XGEN(b.x)], 1u);
            asm volatile("s_waitcnt vmcnt(0)" ::: "memory");
        } else {
            XB_SPIN(xb_ld(&bar[XB_XGEN(b.x)]) == gen, bar);
            __builtin_amdgcn_fence(__ATOMIC_ACQUIRE, "agent");
            asm volatile("s_waitcnt vmcnt(0)" ::: "memory");
        }
    }
    __syncthreads();
}
struct Frame {
    LAS unsigned char* lds;
    int tid, lane, wave, G, bid;
    GAS float* out; GAS unsigned char* ws;
    __device__ __forceinline__ const GAS float* inp(int i) const {
        const __attribute__((address_space(4))) char* ka = (const __attribute__((address_space(4))) char*)__builtin_amdgcn_kernarg_segment_ptr();
        return (const GAS float*)*(volatile const __attribute__((address_space(4))) unsigned long long*)(ka + 8 * i);
    }
};

__device__ __forceinline__ void tr_item(const GAS float* W, int K, int N, GAS bf16* WT, int k0, int n0, int dst_row0, const GAS float* gain, LAS float* scr, int lane) {
    const int kr = lane >> 3, c4 = lane & 7;
    f32x4 v[8];
#pragma unroll
    for (int i = 0; i < 8; ++i) v[i] = __builtin_nontemporal_load((const GAS f32x4*)(W + (size_t)(k0 + 8 * i + kr) * N + n0 + 4 * c4));
    if (gain) {
#pragma unroll
        for (int i = 0; i < 8; ++i) v[i] = v[i] * gain[k0 + 8 * i + kr]; }
#pragma unroll
    for (int i = 0; i < 8; ++i) { LAS float* d = scr + (8 * i + kr) * 33 + 4 * c4; d[0] = v[i].x; d[1] = v[i].y; d[2] = v[i].z; d[3] = v[i].w; }
    LDS_WAIT(); asm volatile("" ::: "memory");
    const int c = lane & 7;
#pragma unroll
    for (int j = 0; j < 4; ++j) { const int n = (lane >> 3) + 8 * j; const LAS float* s = scr + (8 * c) * 33 + n;
        v4u o; o.x = pk2(s[0 * 33], s[1 * 33]); o.y = pk2(s[2 * 33], s[3 * 33]); o.z = pk2(s[4 * 33], s[5 * 33]); o.w = pk2(s[6 * 33], s[7 * 33]);
        *(GAS v4u*)(WT + (size_t)(dst_row0 + n) * K + k0 + 8 * c) = o; }
    LDS_WAIT(); asm volatile("" ::: "memory");
}
__device__ __forceinline__ int pair_row(int n, int Fh) { const int half = n / Fh, j = n - half * Fh; return (j >> 7) * 256 + half * 128 + (j & 127); }
__device__ __forceinline__ void sincos_pi(double r, double& s, double& c) {
    const double x2 = r * r; double ts = 1.0, tc = 1.0, ss = 1.0, cc = 1.0;
#pragma unroll
    for (int k = 1; k <= 14; ++k) { tc *= -x2 / (double)((2 * k - 1) * (2 * k)); cc += tc; ts *= -x2 / (double)((2 * k) * (2 * k + 1)); ss += ts; }
    s = r * ss; c = cc;
}
__device__ __forceinline__ void sincos_big(double ang, double& s, double& c) {
    const double TWO_PI = 6.283185307179586476925286766559; const double k = rint(ang / TWO_PI); sincos_pi(ang - k * TWO_PI, s, c);
}
template <int FIN>
__device__ __forceinline__ void rms_row(const GAS float* xrow, GAS float* xcopy, GAS bf16* orow, GAS float* frow, const GAS float* gain, int lane, const GAS float* slab0, size_t spitch, int ns, const GAS float* gbias) {
    const GAS f32x4* xr = (const GAS f32x4*)xrow + lane;
    f32x4 v[8]; float s = 0.f;
#pragma unroll
    for (int j = 0; j < 8; ++j) v[j] = xr[64 * j];
    if (FIN == 1) {
#pragma unroll 1
        for (int sl = 0; sl < ns; ++sl) { const GAS f32x4* pr = (const GAS f32x4*)(slab0 + (size_t)sl * spitch) + lane;
#pragma unroll
            for (int j = 0; j < 8; ++j) v[j] += pr[64 * j]; } }
    if (FIN == 2) {
        f32x4 z1[8], z2[8];
#pragma unroll
        for (int j = 0; j < 8; ++j) { const int c = 4 * lane + 256 * j; z1[j] = *(const GAS f32x4*)(gbias + c); z2[j] = *(const GAS f32x4*)(gbias + D + c); }
#pragma unroll 1
        for (int sl = 0; sl < ns; ++sl) { const GAS float* pr = slab0 + (size_t)sl * spitch;
#pragma unroll
            for (int j = 0; j < 8; ++j) { const int c = 4 * lane + 256 * j, gc = (c >> 7) * 256 + (c & 127); z1[j] += *(const GAS f32x4*)(pr + gc); z2[j] += *(const GAS f32x4*)(pr + gc + 128); } }
#pragma unroll
        for (int j = 0; j < 8; ++j) { v[j].x += z1[j].x * sigmoidf_(z2[j].x); v[j].y += z1[j].y * sigmoidf_(z2[j].y); v[j].z += z1[j].z * sigmoidf_(z2[j].z); v[j].w += z1[j].w * sigmoidf_(z2[j].w); } }
#pragma unroll
    for (int j = 0; j < 8; ++j) s += (v[j].x * v[j].x + v[j].y * v[j].y) + (v[j].z * v[j].z + v[j].w * v[j].w);
    const float rstd = 1.0f / sqrtf(wave_sum(s) * (1.f / D) + EPS);
    if (xcopy) { GAS f32x4* xc = (GAS f32x4*)xcopy + lane;
#pragma unroll
        for (int j = 0; j < 8; ++j) xc[64 * j] = v[j]; }
#pragma unroll
    for (int j = 0; j < 8; ++j) { f32x4 g = (f32x4){1.f, 1.f, 1.f, 1.f}; if (gain) g = ((const GAS f32x4*)gain)[lane + 64 * j]; v[j] = v[j] * rstd * g; }
    if (orow) { GAS v2u* o8 = (GAS v2u*)orow + lane;
#pragma unroll
        for (int j = 0; j < 8; ++j) { v2u w; w.x = pk2(v[j].x, v[j].y); w.y = pk2(v[j].z, v[j].w); o8[64 * j] = w; } }
    else { GAS f32x4* o = (GAS f32x4*)frow + lane;
#pragma unroll
        for (int j = 0; j < 8; ++j) o[64 * j] = v[j]; }
}
__device__ __forceinline__ void rms_phase(const Frame& F, int mode, const GAS float* gain, int fin, int ns, const GAS float* gbias) {
    const int gw = F.bid * NWAVES + F.wave, NGW = F.G * NWAVES;
    GAS float* X = (GAS float*)(F.ws + WS_X); GAS bf16* XN = (GAS bf16*)(F.ws + WS_XN); const GAS float* SLAB = (const GAS float*)(F.ws + WS_SLAB);
    {
        LAS float* red = (LAS float*)F.lds;
        const int sub = F.wave & 3, rsel = F.wave >> 2;
#pragma unroll 1
        for (int r0 = 2 * F.bid; r0 < MS; r0 += 2 * F.G) {
            const int m = MP + r0 + rsel; GAS float* xr = X + (size_t)m * D + 512 * sub;
            f32x4 v[2]; v[0] = ((const GAS f32x4*)xr)[F.lane]; v[1] = ((const GAS f32x4*)xr)[F.lane + 64];
            if (fin == 1) { const GAS float* sl = SLAB + (size_t)(r0 + rsel) * D + 512 * sub;
                for (int s = 0; s < ns; ++s) { v[0] += ((const GAS f32x4*)(sl + (size_t)s * MS * D))[F.lane]; v[1] += ((const GAS f32x4*)(sl + (size_t)s * MS * D))[F.lane + 64]; } }
            else { f32x4 z1[2], z2[2];
#pragma unroll
                for (int j = 0; j < 2; ++j) { const int c = 512 * sub + 4 * F.lane + 256 * j; z1[j] = *(const GAS f32x4*)(gbias + c); z2[j] = *(const GAS f32x4*)(gbias + D + c); }
                const GAS float* sl = SLAB + (size_t)(r0 + rsel) * 2 * D;
                for (int s = 0; s < ns; ++s) {
#pragma unroll
                    for (int j = 0; j < 2; ++j) { const int c = 512 * sub + 4 * F.lane + 256 * j, gc = (c >> 7) * 256 + (c & 127); z1[j] += *(const GAS f32x4*)(sl + (size_t)s * MS * 2 * D + gc); z2[j] += *(const GAS f32x4*)(sl + (size_t)s * MS * 2 * D + gc + 128); } }
#pragma unroll
                for (int j = 0; j < 2; ++j) { v[j].x += z1[j].x * sigmoidf_(z2[j].x); v[j].y += z1[j].y * sigmoidf_(z2[j].y); v[j].z += z1[j].z * sigmoidf_(z2[j].z); v[j].w += z1[j].w * sigmoidf_(z2[j].w); } }
            float ss = 0.f;
#pragma unroll
            for (int j = 0; j < 2; ++j) ss += (v[j].x * v[j].x + v[j].y * v[j].y) + (v[j].z * v[j].z + v[j].w * v[j].w);
            ss = wave_sum(ss);
            __syncthreads(); if (F.lane == 0) red[F.wave] = ss; __syncthreads();
            const float rstd = 1.0f / sqrtf(((red[4 * rsel] + red[4 * rsel + 1]) + (red[4 * rsel + 2] + red[4 * rsel + 3])) * (1.f / D) + EPS);
            ((GAS f32x4*)xr)[F.lane] = v[0]; ((GAS f32x4*)xr)[F.lane + 64] = v[1];
#pragma unroll
            for (int j = 0; j < 2; ++j) { f32x4 g = (f32x4){1.f, 1.f, 1.f, 1.f}; if (mode != 0) g = *(const GAS f32x4*)(gain + 512 * sub + 4 * (F.lane + 64 * j)); const f32x4 o = v[j] * rstd * g;
                if (mode == 2) *(GAS f32x4*)(F.out + O_YP + (size_t)m * D + 512 * sub + 4 * (F.lane + 64 * j)) = o;
                else { v2u w; w.x = pk2(o.x, o.y); w.y = pk2(o.z, o.w); *(GAS v2u*)(XN + (size_t)m * D + 512 * sub + 4 * (F.lane + 64 * j)) = w; } }
        }
    }
#ifndef REP_RMSP
#define REP_RMSP 0
#endif
    for (int rep = 0; rep <= REP_RMSP; ++rep)
    for (int m = gw; m < MP; m += NGW) {
        if (mode == 2) rms_row<0>(X + (size_t)m * D, nullptr, nullptr, F.out + O_YP + (size_t)m * D, gain, F.lane, nullptr, 0, 0, nullptr);
        else rms_row<0>(X + (size_t)m * D, nullptr, XN + (size_t)m * D, nullptr, mode == 1 ? gain : nullptr, F.lane, nullptr, 0, 0, nullptr);
    }
}

constexpr int IT_IN = 32 * (INW / 32), IT_OUT = 32 * (D / 32), IT_GLU = 32 * (2 * D / 32), IT_GU = 32 * (2 * FF / 32), IT_DN = (FF / 64) * (D / 32);
constexpr int CV_E0 = IT_IN, CV_E1 = CV_E0 + IT_OUT, CV_E2 = CV_E1 + IT_GU, CV_E3 = CV_E2 + IT_DN, CV_E4 = CV_E3 + IT_GLU, CV_E5 = CV_E4 + IT_GU, CV_E6 = CV_E5 + IT_DN,
              CV_E7 = CV_E6 + IT_IN, CV_E8 = CV_E7 + IT_OUT, CV_E9 = CV_E8 + IT_GU, CV_E10 = CV_E9 + IT_DN, CV_E11 = CV_E10 + IT_GLU, CV_E12 = CV_E11 + IT_GU, CV_E13 = CV_E12 + IT_DN;
constexpr int CV_T2E = CV_E3 + 2048, CV_T3E = CV_T2E + 4480, CV_T4E = CV_T3E + 2560;
constexpr int CV_T5E = CV_E6 + 4480;
constexpr int CV_T7E = CV_E10 + 2048, CV_T8E = CV_T7E + 4480, CV_T9E = CV_T8E + 2560;
static_assert(CV_T4E <= CV_E5 && CV_T9E <= CV_E12, "tail ranges stay inside the matrices needed later");
__device__ __forceinline__ void conv_item(const Frame& F, int it, LAS float* scr) {
    int r = it, seg_type, lay;
    if (r < CV_E0) { seg_type = 0; lay = 0; }
    else if (r < CV_E1) { r -= CV_E0; seg_type = 1; lay = 0; }
    else if (r < CV_E2) { r -= CV_E1; seg_type = 3; lay = 0; }
    else if (r < CV_E3) { r -= CV_E2; seg_type = 4; lay = 0; }
    else if (r < CV_E4) { r -= CV_E3; seg_type = 2; lay = 0; }
    else if (r < CV_E5) { r -= CV_E4; seg_type = 3; lay = 1; }
    else if (r < CV_E6) { r -= CV_E5; seg_type = 4; lay = 1; }
    else if (r < CV_E7) { r -= CV_E6; seg_type = 0; lay = 1; }
    else if (r < CV_E8) { r -= CV_E7; seg_type = 1; lay = 1; }
    else if (r < CV_E9) { r -= CV_E8; seg_type = 3; lay = 2; }
    else if (r < CV_E10) { r -= CV_E9; seg_type = 4; lay = 2; }
    else if (r < CV_E11) { r -= CV_E10; seg_type = 2; lay = 1; }
    else if (r < CV_E12) { r -= CV_E11; seg_type = 3; lay = 3; }
    else { r -= CV_E12; seg_type = 4; lay = 3; }
    const GAS float* W; GAS bf16* WT; const GAS float* gain = nullptr; int K = D, N, dst; int nblk;
    if (seg_type == 0) { N = INW; W = F.inp(I_WIN) + (size_t)lay * D * INW; WT = (GAS bf16*)(F.ws + WS_WIN + lay * SZ_WIN); gain = F.inp(I_NME) + lay * D; }
    else if (seg_type == 1) { N = D; W = F.inp(I_WOUT) + (size_t)lay * D * D; WT = (GAS bf16*)(F.ws + WS_WOUT + lay * SZ_WOUT); }
    else if (seg_type == 2) { N = 2 * D; W = F.inp(I_WGLU) + (size_t)lay * D * 2 * D; WT = (GAS bf16*)(F.ws + WS_WGLU + lay * SZ_WGLU); }
    else if (seg_type == 3) { N = 2 * FF; W = F.inp(I_WGU) + (size_t)lay * D * 2 * FF; WT = (GAS bf16*)(F.ws + WS_WGU + lay * SZ_WGU); gain = F.inp(I_NF) + lay * D; }
    else { N = D; K = FF; W = F.inp(I_WDN) + (size_t)lay * FF * D; WT = (GAS bf16*)(F.ws + WS_WDN + lay * SZ_WDN); }
    nblk = N / 32; const int kb = r / nblk, nb = r - kb * nblk;
    dst = seg_type == 2 ? pair_row(32 * nb, D) : (seg_type == 3 ? pair_row(32 * nb, FF) : 32 * nb);
    tr_item(W, K, N, WT, 64 * kb, 32 * nb, dst, gain, scr, F.lane);
}
__device__ __forceinline__ void conv_in_tail(const Frame& F, int lo, int hi, int nbusy) {
    if (F.bid < nbusy) return;
    LAS float* scr = (LAS float*)(F.lds + F.wave * 16384);
    const int w = (F.bid - nbusy) * NWAVES + F.wave, nw = (F.G - nbusy) * NWAVES;
    for (int it = lo + w; it < hi; it += nw) conv_item(F, it, scr);
}

__device__ __forceinline__ void p0_prologue(const Frame& F) {
    const int gw = F.bid * NWAVES + F.wave, NGW = F.G * NWAVES;
    { LAS float* scr = (LAS float*)(F.lds + F.wave * 16384);
      constexpr int N1 = CV_E0, N2 = CV_E6 - CV_T4E, N3 = CV_E13 - CV_T9E;
      for (int i = gw; i < N1 + N2 + N3; i += NGW) { const int it = i < N1 ? i : (i < N1 + N2 ? CV_T4E + (i - N1) : CV_T9E + (i - N1 - N2)); conv_item(F, it, scr); } }
    { GAS float* X = (GAS float*)(F.ws + WS_X); GAS bf16* XN = (GAS bf16*)(F.ws + WS_XN);
      for (int m = gw; m < M; m += NGW) { const GAS float* src = m < MP ? F.inp(I_XP) + (size_t)m * D : F.inp(I_XS) + (size_t)(m - MP) * D;
          rms_row<0>(src, X + (size_t)m * D, XN + (size_t)m * D, nullptr, nullptr, F.lane, nullptr, 0, 0, nullptr); } }
    const int gt = F.bid * NTHR + F.tid, NGT = F.G * NTHR;
    { GAS float* COS = (GAS float*)(F.ws + WS_ROPE); GAS float* SIN = COS + NPOS * 128;
      for (int i = gt; i < NPOS * 128; i += NGT) { const int pi = i >> 7, f = i & 127; const double pos = pi < SEQ ? (double)pi : (double)(PAST + pi - SEQ);
          const double inv = exp(-9.2103403719761827361 * (double)f / 127.0); double s, c; sincos_big(pos * inv, s, c); COS[i] = (float)c; SIN[i] = (float)s; } }
    { GAS bf16* LW = (GAS bf16*)(F.ws + WS_LRUW);
      for (int i = gt; i < 2 * 8 * 256 * 128; i += NGT) { const int k = i & 127, j2 = (i >> 7) & 255, en = i >> 15;
          const GAS float* src = (j2 < 128 ? F.inp(I_WA) : F.inp(I_WX)) + ((size_t)en * 128 + k) * 128 + (j2 & 127); LW[i] = (bf16)f2bf(*src); }
      GAS float* LC = (GAS float*)(F.ws + WS_LRUC);
      for (int i = gt; i < 2 * 1024; i += NGT) LC[i] = 8.0f * log1pf(expf(-F.inp(I_LAM)[i])); }
    { GAS bf16* BB = (GAS bf16*)(F.ws + WS_S5BB); GAS bf16* CM = (GAS bf16*)(F.ws + WS_S5CM); GAS float* AB = (GAS float*)(F.ws + WS_S5AB);
      for (int i = gt; i < 2 * SG * SP; i += NGT) { const int p = i & 63, g = (i >> 6) & 127, o = i >> 13;
          const double dt = exp((double)F.inp(I_LDT)[o * SG + g]), are = (double)F.inp(I_ARE)[i], aim = (double)F.inp(I_AIM)[i];
          double s, c; sincos_big(aim * dt, s, c); const double mag = exp(are * dt), abr = mag * c, abi = mag * s;
          double s2, c2; sincos_big(128.0 * aim * dt, s2, c2); const double mag2 = exp(128.0 * are * dt);
          const double den = are * are + aim * aim, nr = abr - 1.0, ni = abi, fr = (nr * are + ni * aim) / den, fi = (ni * are - nr * aim) / den;
          AB[(size_t)i * 4 + 0] = (float)abr; AB[(size_t)i * 4 + 1] = (float)abi; AB[(size_t)i * 4 + 2] = (float)(mag2 * c2); AB[(size_t)i * 4 + 3] = (float)(mag2 * s2);
          const GAS float* bre = F.inp(I_BRE) + (size_t)i * 16; const GAS float* bim = F.inp(I_BIM) + (size_t)i * 16;
          GAS bf16* bbr = BB + ((size_t)(o * SG + g) * 128 + 2 * p) * 16; GAS bf16* bbi = BB + ((size_t)(o * SG + g) * 128 + 2 * p + 1) * 16;
          for (int k = 0; k < 16; ++k) { const double br = bre[k], bi = bim[k]; bbr[k] = (bf16)f2bf((float)(fr * br - fi * bi)); bbi[k] = (bf16)f2bf((float)(fr * bi + fi * br)); }
          const GAS float* cre = F.inp(I_CRE) + (size_t)(o * SG + g) * 16 * 64; const GAS float* cim = F.inp(I_CIM) + (size_t)(o * SG + g) * 16 * 64;
          GAS bf16* cm = CM + (size_t)(o * SG + g) * 16 * 128;
          for (int k = 0; k < 16; ++k) { cm[k * 128 + 2 * p] = (bf16)f2bf(cre[k * 64 + p]); cm[k * 128 + 2 * p + 1] = (bf16)f2bf(-cim[k * 64 + p]); } }
      { GAS v2u* PW = (GAS v2u*)(F.ws + WS_S5PW);
        for (int it = gt; it < 2 * SG * SP * 8; it += NGT) { const int i = it >> 3, part = it & 7, p = i & 63, og = i >> 6;
            const double dt = exp((double)F.inp(I_LDT)[og]), are = (double)F.inp(I_ARE)[i], aim = (double)F.inp(I_AIM)[i];
            double s, c; sincos_big(aim * dt, s, c); const double mag = exp(are * dt), ar = mag * c, ai = mag * s;
            const double a2r = ar * ar - ai * ai, a2i = 2.0 * ar * ai, a3r = a2r * ar - a2i * ai, a3i = a2r * ai + a2i * ar, a4r = a2r * a2r - a2i * a2i, a4i = 2.0 * a2r * a2i;
            const double a8r = a4r * a4r - a4i * a4i, a8i = 2.0 * a4r * a4i, a16r = a8r * a8r - a8i * a8i, a16i = 2.0 * a8r * a8i;
            double wr = 1.0, wi = 0.0;
            for (int q = 0; q < part; ++q) { const double nr = wr * a16r - wi * a16i, ni = wr * a16i + wi * a16r; wr = nr; wi = ni; }
            for (int jj = 0; jj < 4; ++jj) { const int j = 4 * part + jj, sq = 31 - j, sub = sq >> 2, fq = sq & 3;
                const double p1r = wr * ar - wi * ai, p1i = wr * ai + wi * ar, p2r = wr * a2r - wi * a2i, p2i = wr * a2i + wi * a2r, p3r = wr * a3r - wi * a3i, p3i = wr * a3i + wi * a3r;
                const size_t idx = ((size_t)(og * 8 + sub) * 8 + (p >> 3)) * 64 + 16 * fq + 2 * (p & 7);
                v2u re, im; re.x = pk2((float)p3r, (float)p2r); re.y = pk2((float)p1r, (float)wr); im.x = pk2((float)p3i, (float)p2i); im.y = pk2((float)p1i, (float)wi);
                PW[idx] = re; PW[idx + 1] = im;
                const double nr = wr * a4r - wi * a4i, ni = wr * a4i + wi * a4r; wr = nr; wi = ni; } } } }
}
__device__ __forceinline__ float ret_log2g(int h) { return log2f(1.0f - exp2f(-5.0f - (float)h)); }

__device__ __forceinline__ void rot8(const v4u a, const v4u b, const GAS float* cs, const GAS float* sn, float sc, float (&o1)[8], float (&o2)[8]) {
    const f32x4 c0 = ((const GAS f32x4*)cs)[0], c1 = ((const GAS f32x4*)cs)[1], s0 = ((const GAS f32x4*)sn)[0], s1 = ((const GAS f32x4*)sn)[1];
    const float c[8] = {c0.x, c0.y, c0.z, c0.w, c1.x, c1.y, c1.z, c1.w}, s[8] = {s0.x, s0.y, s0.z, s0.w, s1.x, s1.y, s1.z, s1.w};
    const unsigned aw[4] = {a.x, a.y, a.z, a.w}, bw[4] = {b.x, b.y, b.z, b.w};
#pragma unroll
    for (int j = 0; j < 4; ++j) { const float x1l = bflo(aw[j]), x1h = bfhi(aw[j]), x2l = bflo(bw[j]), x2h = bfhi(bw[j]);
        o1[2 * j] = (x1l * c[2 * j] - x2l * s[2 * j]) * sc; o1[2 * j + 1] = (x1h * c[2 * j + 1] - x2h * s[2 * j + 1]) * sc;
        o2[2 * j] = (x2l * c[2 * j] + x1l * s[2 * j]) * sc; o2[2 * j + 1] = (x2h * c[2 * j + 1] + x1h * s[2 * j + 1]) * sc; }
}
__device__ __forceinline__ void ret_stage_rot_qk(const Frame& F, LAS unsigned char* qimg, LAS unsigned char* kimg, const GAS bf16* qsrc, const GAS bf16* ksrc, int pos0, float ksc) {
    const GAS float* COS = (const GAS float*)(F.ws + WS_ROPE); const GAS float* SIN = COS + NPOS * 128;
#pragma unroll 1
    for (int it0 = 0; it0 < 4; it0 += 2) {
        v4u qa[2], qb[2], ka[2], kb[2]; f32x4 c0[2], c1[2], s0[2], s1[2];
#pragma unroll
        for (int u = 0; u < 2; ++u) { const int item = F.tid + NTHR * (it0 + u), m = item >> 4, f8 = item & 15;
            const GAS bf16* qp = qsrc + (size_t)m * INW + 8 * f8; const GAS bf16* kp = ksrc + (size_t)m * INW + 8 * f8;
            qa[u] = *(const GAS v4u*)qp; qb[u] = *(const GAS v4u*)(qp + 128); ka[u] = *(const GAS v4u*)kp; kb[u] = *(const GAS v4u*)(kp + 128);
            const GAS float* cp = COS + (size_t)(pos0 + m) * 128 + 8 * f8; const GAS float* sp = SIN + (size_t)(pos0 + m) * 128 + 8 * f8;
            c0[u] = *(const GAS f32x4*)cp; c1[u] = *(const GAS f32x4*)(cp + 4); s0[u] = *(const GAS f32x4*)sp; s1[u] = *(const GAS f32x4*)(sp + 4); }
#pragma unroll
        for (int u = 0; u < 2; ++u) { const int item = F.tid + NTHR * (it0 + u), m = item >> 4, f8 = item & 15;
            const float c[8] = {c0[u].x, c0[u].y, c0[u].z, c0[u].w, c1[u].x, c1[u].y, c1[u].z, c1[u].w}, sn[8] = {s0[u].x, s0[u].y, s0[u].z, s0[u].w, s1[u].x, s1[u].y, s1[u].z, s1[u].w};
#pragma unroll
            for (int w = 0; w < 2; ++w) {
                const v4u a = w ? ka[u] : qa[u], b = w ? kb[u] : qb[u]; const float sc = w ? ksc : 1.0f;
                const unsigned aw[4] = {a.x, a.y, a.z, a.w}, bw[4] = {b.x, b.y, b.z, b.w}; unsigned o1[4], o2[4];
#pragma unroll
                for (int j = 0; j < 4; ++j) { const float x1l = bflo(aw[j]), x1h = bfhi(aw[j]), x2l = bflo(bw[j]), x2h = bfhi(bw[j]);
                    o1[j] = pk2((x1l * c[2 * j] - x2l * sn[2 * j]) * sc, (x1h * c[2 * j + 1] - x2h * sn[2 * j + 1]) * sc);
                    o2[j] = pk2((x2l * c[2 * j] + x1l * sn[2 * j]) * sc, (x2h * c[2 * j + 1] + x1h * sn[2 * j + 1]) * sc); }
                LAS unsigned char* img = w ? kimg : qimg; v4u w1, w2; w1.x = o1[0]; w1.y = o1[1]; w1.z = o1[2]; w1.w = o1[3]; w2.x = o2[0]; w2.y = o2[1]; w2.z = o2[2]; w2.w = o2[3];
                *(LAS v4u*)(img + m * 528 + 16 * f8) = w1; *(LAS v4u*)(img + m * 528 + 256 + 16 * f8) = w2; } }
    }
}
__device__ __forceinline__ void ret_stage_vT(const Frame& F, LAS unsigned char* img, const GAS bf16* src) {
    const int m = F.tid >> 2, e8l = F.tid & 3; v4u a[8];
#pragma unroll
    for (int it = 0; it < 8; ++it) a[it] = *(const GAS v4u*)(src + (size_t)m * INW + 8 * (e8l + 4 * it));
#pragma unroll
    for (int it = 0; it < 8; ++it) { const int e8 = e8l + 4 * it; const unsigned aw[4] = {a[it].x, a[it].y, a[it].z, a[it].w};
#pragma unroll
        for (int j = 0; j < 4; ++j) { *(LAS bf16*)(img + (8 * e8 + 2 * j) * 272 + 2 * m) = (bf16)(aw[j] & 0xffffu); *(LAS bf16*)(img + (8 * e8 + 2 * j + 1) * 272 + 2 * m) = (bf16)(aw[j] >> 16); } }
}

__device__ __forceinline__ void ret_scan_unit(const Frame& F, int e_layer, int b, int h, int dq, int eq) {
    const GAS bf16* PROJ = (const GAS bf16*)(F.ws + WS_PROJ);
    const GAS float* COS = (const GAS float*)(F.ws + WS_ROPE); const GAS float* SIN = COS + NPOS * 128;
    GAS bf16* SB = (GAS bf16*)(F.ws + WS_UT) + (size_t)(b * RH + h) * (NCH - 1) * 65536;
    const float lg2 = ret_log2g(h), dec = exp2f(128.0f * lg2);
    const int fr = F.lane & 15, fq = F.lane >> 4, db = F.wave >> 1, eb0 = 2 * (F.wave & 1);
    const int km = F.tid >> 2, kf4 = F.tid & 3, d1 = 32 * dq + 8 * kf4;
    const float ksc = 0.0625f * exp2f((float)(127 - km) * lg2);
    const GAS bf16* kp = PROJ + (size_t)(b * SEQ + km) * INW + 1024 + h * 256 + d1;
    const GAS float* cp = COS + (size_t)km * 128 + d1; const GAS float* sp = SIN + (size_t)km * 128 + d1;
    const GAS bf16* vp0 = PROJ + (size_t)(b * SEQ + km) * INW + 2048 + h * 256 + 64 * eq + 8 * kf4;
    v4u ka, kb, va, vb; f32x4 c0, c1, s0, s1;
    ka = *(const GAS v4u*)kp; kb = *(const GAS v4u*)(kp + 128); c0 = *(const GAS f32x4*)cp; c1 = *(const GAS f32x4*)(cp + 4); s0 = *(const GAS f32x4*)sp; s1 = *(const GAS f32x4*)(sp + 4);
    va = *(const GAS v4u*)vp0; vb = *(const GAS v4u*)(vp0 + 32);
    f32x4 acc[2] = {(f32x4){0.f, 0.f, 0.f, 0.f}, (f32x4){0.f, 0.f, 0.f, 0.f}};
    const int dl0 = 16 * db + 4 * fq, dg0 = dl0 < 32 ? 32 * dq + dl0 : 128 + 32 * dq + dl0 - 32;
    __syncthreads();
#pragma unroll 1
    for (int c = 0; c < NCH; ++c) {
        LAS unsigned char* KT = F.lds + (c & 1) * 34816; LAS unsigned char* VT = KT + 17408;
        if (c > 0) {
#pragma unroll
            for (int t = 0; t < 2; ++t) { v2u w; w.x = pk2(acc[t][0], acc[t][1]); w.y = pk2(acc[t][2], acc[t][3]);
                *(GAS v2u*)(SB + ((size_t)(c - 1) * 256 + 64 * eq + 16 * (eb0 + t) + fr) * 256 + dg0) = w; } }
        {
            const float cc[8] = {c0.x, c0.y, c0.z, c0.w, c1.x, c1.y, c1.z, c1.w}, ss[8] = {s0.x, s0.y, s0.z, s0.w, s1.x, s1.y, s1.z, s1.w};
            const unsigned aw[4] = {ka.x, ka.y, ka.z, ka.w}, bw[4] = {kb.x, kb.y, kb.z, kb.w};
#pragma unroll
            for (int j = 0; j < 8; ++j) { const float x1 = (j & 1) ? bfhi(aw[j >> 1]) : bflo(aw[j >> 1]), x2 = (j & 1) ? bfhi(bw[j >> 1]) : bflo(bw[j >> 1]);
                *(LAS bf16*)(KT + (8 * kf4 + j) * 272 + 2 * km) = (bf16)f2bf((x1 * cc[j] - x2 * ss[j]) * ksc);
                *(LAS bf16*)(KT + (32 + 8 * kf4 + j) * 272 + 2 * km) = (bf16)f2bf((x2 * cc[j] + x1 * ss[j]) * ksc); }
            const unsigned vw[8] = {va.x, va.y, va.z, va.w, vb.x, vb.y, vb.z, vb.w};
#pragma unroll
            for (int j = 0; j < 8; ++j) { const int e8 = kf4 + 4 * (j >> 2);
                *(LAS bf16*)(VT + (8 * e8 + 2 * (j & 3)) * 272 + 2 * km) = (bf16)(vw[j] & 0xffffu); *(LAS bf16*)(VT + (8 * e8 + 2 * (j & 3) + 1) * 272 + 2 * km) = (bf16)(vw[j] >> 16); }
        }
        if (c + 1 < NCH) {
            const size_t ro = (size_t)(c + 1) * CH * INW; const size_t po = (size_t)(c + 1) * CH * 128;
            ka = *(const GAS v4u*)(kp + ro); kb = *(const GAS v4u*)(kp + ro + 128); c0 = *(const GAS f32x4*)(cp + po); c1 = *(const GAS f32x4*)(cp + po + 4); s0 = *(const GAS f32x4*)(sp + po); s1 = *(const GAS f32x4*)(sp + po + 4);
            va = *(const GAS v4u*)(vp0 + ro); vb = *(const GAS v4u*)(vp0 + ro + 32); }
        asm volatile("s_waitcnt lgkmcnt(0)" ::: "memory"); __builtin_amdgcn_s_barrier(); asm volatile("" ::: "memory");
        acc[0] = acc[0] * dec; acc[1] = acc[1] * dec;
#pragma unroll
        for (int ks = 0; ks < 4; ++ks) { const bf16x8 af = *(const LAS bf16x8*)(KT + (16 * db + fr) * 272 + (32 * ks + 8 * fq) * 2);
#pragma unroll
            for (int t = 0; t < 2; ++t) { const bf16x8 bv = *(const LAS bf16x8*)(VT + (16 * (eb0 + t) + fr) * 272 + (32 * ks + 8 * fq) * 2); acc[t] = MFMA32(af, bv, acc[t]); } }
    }
    GAS float* o = F.out + O_RETP + (size_t)((e_layer * BATCH + b) * RH + h) * 65536;
#pragma unroll
    for (int t = 0; t < 2; ++t)
#pragma unroll
        for (int r = 0; r < 4; ++r) o[(size_t)(dg0 + r) * 256 + 64 * eq + 16 * (eb0 + t) + fr] = acc[t][r];
}

__device__ __forceinline__ void ret_c_unit(const Frame& F, int b, int h, int c) {
    LAS unsigned char* QS = F.lds; LAS unsigned char* R2 = F.lds + 67584;
    const GAS bf16* PROJ = (const GAS bf16*)(F.ws + WS_PROJ); const int row0 = b * SEQ + CH * c;
    const float lg2 = ret_log2g(h);
    __syncthreads();
    ret_stage_rot_qk(F, QS, R2, PROJ + (size_t)row0 * INW + h * 256, PROJ + (size_t)row0 * INW + 1024 + h * 256, CH * c, 0.0625f);
    __syncthreads();
    const int fr = F.lane & 15, fq = F.lane >> 4, w = F.wave;
    const int nl = 16 * w + fr;
    bf16x8 pf[4];
    { f32x4 ap[8];
#pragma unroll
      for (int mb = 0; mb < 8; ++mb) ap[mb] = (f32x4){0.f, 0.f, 0.f, 0.f};
#pragma unroll
      for (int ks = 0; ks < 8; ++ks) { const bf16x8 qf = *(const LAS bf16x8*)(QS + nl * 528 + (32 * ks + 8 * fq) * 2);
#pragma unroll
          for (int mb = 0; mb < 8; ++mb) { const bf16x8 kf = *(const LAS bf16x8*)(R2 + (16 * mb + fr) * 528 + (32 * ks + 8 * fq) * 2); ap[mb] = MFMA32(kf, qf, ap[mb]); }
          __builtin_amdgcn_sched_barrier(0); }
#pragma unroll
      for (int mb = 0; mb < 8; ++mb)
#pragma unroll
          for (int r = 0; r < 4; ++r) { const int m = 16 * mb + 4 * fq + r, df = nl - m; ap[mb][r] = df >= 0 ? ap[mb][r] * exp2f((float)df * lg2) : 0.f; }
#pragma unroll
      for (int s = 0; s < 4; ++s) { v4u t; t.x = pk2(ap[2 * s][0], ap[2 * s][1]); t.y = pk2(ap[2 * s][2], ap[2 * s][3]); t.z = pk2(ap[2 * s + 1][0], ap[2 * s + 1][1]); t.w = pk2(ap[2 * s + 1][2], ap[2 * s + 1][3]);
          pf[s] = __builtin_bit_cast(bf16x8, t); }
      asm volatile("" : "+v"(pf[0]), "+v"(pf[1]), "+v"(pf[2]), "+v"(pf[3])); }
    f32x4 acc[16];
#pragma unroll
    for (int eb = 0; eb < 16; ++eb) acc[eb] = (f32x4){0.f, 0.f, 0.f, 0.f};
#ifndef RC_NO_S
    if (c > 0) {
        const GAS bf16* SB = (const GAS bf16*)(F.ws + WS_UT) + ((size_t)(b * RH + h) * (NCH - 1) + c - 1) * 65536;
#pragma unroll
        for (int half = 0; half < 2; ++half) {
            __syncthreads();
            { const GAS bf16* sp = SB + (size_t)(128 * half + (F.tid >> 5)) * 256 + 8 * (F.tid & 31); LAS unsigned char* dp = R2 + (F.tid >> 5) * 528 + 16 * (F.tid & 31);
#pragma unroll 1
              for (int ih = 0; ih < 2; ++ih) { v4u t[4];
#pragma unroll
                  for (int it = 0; it < 4; ++it) t[it] = *(const GAS v4u*)(sp + (size_t)(16 * (4 * ih + it)) * 256);
#pragma unroll
                  for (int it = 0; it < 4; ++it) *(LAS v4u*)(dp + 16 * (4 * ih + it) * 528) = t[it]; } }
            __syncthreads();
#pragma unroll
            for (int ks = 0; ks < 8; ++ks) { const bf16x8 qf = *(const LAS bf16x8*)(QS + nl * 528 + (32 * ks + 8 * fq) * 2);
#pragma unroll
                for (int eb = 0; eb < 8; ++eb) { const bf16x8 sf = *(const LAS bf16x8*)(R2 + (16 * eb + fr) * 528 + (32 * ks + 8 * fq) * 2); acc[8 * half + eb] = MFMA32(sf, qf, acc[8 * half + eb]); }
                __builtin_amdgcn_sched_barrier(0); }
            asm volatile("" : "+v"(acc[8 * half + 0]), "+v"(acc[8 * half + 1]), "+v"(acc[8 * half + 2]), "+v"(acc[8 * half + 3]), "+v"(acc[8 * half + 4]), "+v"(acc[8 * half + 5]), "+v"(acc[8 * half + 6]), "+v"(acc[8 * half + 7]));
        }
        const float qd = exp2f((float)(nl + 1) * lg2);
#pragma unroll
        for (int eb = 0; eb < 16; ++eb) acc[eb] = acc[eb] * qd;
    }
#endif
#ifndef RC_NO_PV
    __syncthreads();
    ret_stage_vT(F, R2, PROJ + (size_t)row0 * INW + 2048 + h * 256);
    __syncthreads();
#pragma unroll
    for (int s = 0; s < 4; ++s)
#pragma unroll
        for (int eh = 0; eh < 2; ++eh) {
#pragma unroll
            for (int e8 = 0; e8 < 8; ++e8) { const int eb = 8 * eh + e8; const LAS unsigned char* vp = R2 + (16 * eb + fr) * 272 + (32 * s + 4 * fq) * 2;
                const v2u lo = *(const LAS v2u*)vp, hi = *(const LAS v2u*)(vp + 32); v4u t; t.x = lo.x; t.y = lo.y; t.z = hi.x; t.w = hi.y;
                acc[eb] = MFMA32(__builtin_bit_cast(bf16x8, t), pf[s], acc[eb]); }
            __builtin_amdgcn_sched_barrier(0); }
#endif
    float ss = 0.f;
#pragma unroll
    for (int eb = 0; eb < 16; ++eb) ss += (acc[eb][0] * acc[eb][0] + acc[eb][1] * acc[eb][1]) + (acc[eb][2] * acc[eb][2] + acc[eb][3] * acc[eb][3]);
    ss += __shfl_xor(ss, 16); ss += __shfl_xor(ss, 32);
    const float rstd = 1.0f / sqrtf(ss * (1.0f / 256.0f) + EPS);
    const GAS bf16* grp = PROJ + (size_t)(row0 + nl) * INW + 3072 + h * 256 + 4 * fq; GAS bf16* op = (GAS bf16*)(F.ws + WS_CAT) + (size_t)(row0 + nl) * D + h * 256 + 4 * fq;
    v2u gv[16];
#pragma unroll
    for (int eb = 0; eb < 16; ++eb) gv[eb] = *(const GAS v2u*)(grp + 16 * eb);
#pragma unroll
    for (int eb = 0; eb < 16; ++eb) { const v2u g = gv[eb];
        v2u o; o.x = pk2(acc[eb][0] * rstd * siluf_(bflo(g.x)), acc[eb][1] * rstd * siluf_(bfhi(g.x))); o.y = pk2(acc[eb][2] * rstd * siluf_(bflo(g.y)), acc[eb][3] * rstd * siluf_(bfhi(g.y)));
        *(GAS v2u*)(op + 16 * eb) = o; }
}

template <int PM>
__device__ __forceinline__ void ret_s_unit(const Frame& F, int e_layer, int b, int h) {
    LAS float* QK = (LAS float*)F.lds;
    LAS float* VS = QK + 2048;
    LAS float* SC = VS + 1024;
    LAS float* RED = SC + 16;
    LAS float* OS = RED + 8192;
    LAS float* NRM = OS + 1024;
    const GAS bf16* PROJ = (const GAS bf16*)(F.ws + WS_PROJ); const int row0 = MP + b * DEC_T;
    const GAS float* COS = (const GAS float*)(F.ws + WS_ROPE); const GAS float* SIN = COS + NPOS * 128;
    const float lg2 = ret_log2g(h);
    __syncthreads();
    {
#pragma unroll
      for (int it = 0; it < 2; ++it) { const int item = F.tid + NTHR * it, f = item & 127, t = (item >> 7) & 3, isk = item >> 9;
          const GAS bf16* p = PROJ + (size_t)(row0 + t) * INW + isk * 1024 + h * 256; const float x1 = bf2f(p[f]), x2 = bf2f(p[128 + f]);
          const float c = COS[(SEQ + t) * 128 + f], s = SIN[(SEQ + t) * 128 + f]; float sc = isk ? 0.0625f * exp2f((float)(3 - t) * lg2) : 1.0f;
          QK[f * 8 + isk * 4 + t] = (x1 * c - x2 * s) * sc; QK[(128 + f) * 8 + isk * 4 + t] = (x2 * c + x1 * s) * sc; }
#pragma unroll
      for (int it = 0; it < 2; ++it) { const int item = F.tid + NTHR * it, e = item & 255, t = item >> 8; VS[t * 256 + e] = bf2f(PROJ[(size_t)(row0 + t) * INW + 2048 + h * 256 + e]); }
    }
    __syncthreads();
    { const int pr = F.tid >> 5, n = pr >> 2, m = pr & 3, l32 = F.tid & 31; float s = 0.f;
#pragma unroll
      for (int j = 0; j < 8; ++j) { const int d = l32 + 32 * j; s += QK[d * 8 + n] * QK[d * 8 + 4 + m]; }
#pragma unroll
      for (int o = 1; o < 32; o <<= 1) s += __shfl_xor(s, o);
      if (l32 == 0) { s *= exp2f(-(float)(3 - m) * lg2); SC[n * 4 + m] = n >= m ? s * exp2f((float)(n - m) * lg2) : 0.f; } }
    const int eg = F.tid & 63, dg = F.tid >> 6;
    const GAS float* s0 = F.inp(I_SRET) + ((size_t)(e_layer * DEC_B + b) * RH + h) * 65536;
    GAS float* s1 = F.out + O_RETS + ((size_t)(e_layer * DEC_B + b) * RH + h) * 65536;
    const float dec = exp2f(4.0f * lg2);
    f32x4 v[4], oa[4];
#pragma unroll
    for (int m = 0; m < 4; ++m) { v[m] = *(const LAS f32x4*)(VS + m * 256 + 4 * eg); oa[m] = (f32x4){0.f, 0.f, 0.f, 0.f}; }
    if (PM != 1)
    {
        f32x4 ring[8];
#pragma unroll
        for (int j = 0; j < 8; ++j) ring[j] = __builtin_nontemporal_load((const GAS f32x4*)(s0 + (size_t)(32 * dg + j) * 256 + 4 * eg));
#pragma unroll 1
        for (int bt = 0; bt < 4; ++bt) { const int d0 = 32 * dg + 8 * bt; const int dn = bt < 3 ? d0 + 8 : d0;
#pragma unroll
            for (int j = 0; j < 8; ++j) { const int d = d0 + j; const f32x4 st = ring[j];
                const f32x4 q = *(const LAS f32x4*)(QK + d * 8), k = *(const LAS f32x4*)(QK + d * 8 + 4);
                oa[0] += st * q.x; oa[1] += st * q.y; oa[2] += st * q.z; oa[3] += st * q.w;
                const f32x4 sn = st * dec + v[0] * k.x + v[1] * k.y + v[2] * k.z + v[3] * k.w;
                __builtin_nontemporal_store(sn, (GAS f32x4*)(s1 + (size_t)d * 256 + 4 * eg));
                ring[j] = __builtin_nontemporal_load((const GAS f32x4*)(s0 + (size_t)(dn + j) * 256 + 4 * eg)); } }
    }
#pragma unroll
    for (int n = 0; n < 4; ++n) *(LAS f32x4*)(RED + (dg * 4 + n) * 256 + 4 * eg) = oa[n];
    __syncthreads();
    {
#pragma unroll
      for (int it = 0; it < 2; ++it) { const int item = F.tid + NTHR * it, e = item & 255, n = item >> 8; float s = 0.f;
#pragma unroll
          for (int g8 = 0; g8 < 8; ++g8) s += RED[(g8 * 4 + n) * 256 + e];
          s *= exp2f((float)(n + 1) * lg2);
#pragma unroll
          for (int m = 0; m < 4; ++m) s += SC[n * 4 + m] * VS[m * 256 + e];
          OS[n * 256 + e] = s; } }
    __syncthreads();
    if (F.wave < 4) { const int n = F.wave; float ss = 0.f;
#pragma unroll
        for (int j = 0; j < 4; ++j) { const float x = OS[n * 256 + F.lane + 64 * j]; ss += x * x; }
        ss = wave_sum(ss); if (F.lane == 0) NRM[n] = 1.0f / sqrtf(ss * (1.0f / 256.0f) + EPS); }
    __syncthreads();
#pragma unroll
    for (int it = 0; it < 2; ++it) { const int item = F.tid + NTHR * it, e = item & 255, n = item >> 8;
        const float g = bf2f(PROJ[(size_t)(row0 + n) * INW + 3072 + h * 256 + e]);
        ((GAS bf16*)(F.ws + WS_CAT))[(size_t)(row0 + n) * D + h * 256 + e] = (bf16)f2bf(OS[n * 256 + e] * NRM[n] * siluf_(g)); }
}
template <int MODE>
__device__ __forceinline__ void lru_unit(const Frame& F, int e_layer, int tile_b, int tile_c, int n, bool stage_w) {
    LAS unsigned char* XC = F.lds;
    LAS unsigned char* WT = F.lds + 34816;
    const GAS bf16* PROJ = (const GAS bf16*)(F.ws + WS_PROJ);
    const int row0 = MODE == 2 ? MP + 128 * tile_c : tile_b * SEQ + CH * tile_c;
    __syncthreads();
    if (stage_w) { const GAS bf16* LW = (const GAS bf16*)(F.ws + WS_LRUW) + (size_t)(e_layer * 8 + n) * 256 * 128; v4u t[8];
#pragma unroll
      for (int it = 0; it < 8; ++it) { const int item = F.tid + NTHR * it, r = item >> 4, c16 = item & 15; t[it] = *(const GAS v4u*)(LW + r * 128 + 8 * c16); }
#pragma unroll
      for (int it = 0; it < 8; ++it) { const int item = F.tid + NTHR * it, r = item >> 4, c16 = item & 15; *(LAS v4u*)(WT + r * 272 + 16 * c16) = t[it]; } }
    { const int c8 = F.tid & 15;
      const GAS float* cw = F.inp(I_CW) + (size_t)e_layer * 4 * LRU_W + n * 128 + 8 * c8; const GAS float* cb = F.inp(I_CB) + (size_t)e_layer * LRU_W + n * 128 + 8 * c8;
      float wv[4][8], bias[8];
      { const f32x4 b0 = *(const GAS f32x4*)cb, b1 = *(const GAS f32x4*)(cb + 4); bias[0] = b0.x; bias[1] = b0.y; bias[2] = b0.z; bias[3] = b0.w; bias[4] = b1.x; bias[5] = b1.y; bias[6] = b1.z; bias[7] = b1.w; }
#pragma unroll
      for (int kk = 0; kk < 4; ++kk) { const f32x4 w0 = *(const GAS f32x4*)(cw + (3 - kk) * LRU_W), w1 = *(const GAS f32x4*)(cw + (3 - kk) * LRU_W + 4);
          wv[kk][0] = w0.x; wv[kk][1] = w0.y; wv[kk][2] = w0.z; wv[kk][3] = w0.w; wv[kk][4] = w1.x; wv[kk][5] = w1.y; wv[kk][6] = w1.z; wv[kk][7] = w1.w; }
#pragma unroll 1
      for (int ih = 0; ih < 2; ++ih) {
      v4u xr[2][4];
#pragma unroll
      for (int it = 0; it < 2; ++it) { const int tok = (F.tid >> 4) + 32 * (2 * ih + it);
#pragma unroll
          for (int kk = 0; kk < 4; ++kk) { const int tq = MODE == 2 ? (tok & 3) - kk : CH * tile_c + tok - kk;
              xr[it][kk] = (v4u){0u, 0u, 0u, 0u};
              if (tq >= 0) xr[it][kk] = *(const GAS v4u*)(PROJ + (size_t)(row0 + tok - kk) * INW + 4096 + n * 128 + 8 * c8); } }
#pragma unroll
      for (int it = 0; it < 2; ++it) { const int tok = (F.tid >> 4) + 32 * (2 * ih + it);
          float acc[8];
#pragma unroll
          for (int j = 0; j < 8; ++j) acc[j] = bias[j];
#pragma unroll
          for (int kk = 0; kk < 4; ++kk) { const v4u a = xr[it][kk]; float x[8] = {bflo(a.x), bfhi(a.x), bflo(a.y), bfhi(a.y), bflo(a.z), bfhi(a.z), bflo(a.w), bfhi(a.w)};
              if (MODE == 2) { const int tq = (tok & 3) - kk;
                  if (tq < 0) { const int bb = 32 * tile_c + (tok >> 2); const GAS float* sp = F.inp(I_SCONV) + ((size_t)(e_layer * DEC_B + bb) * 3 + (3 + tq)) * LRU_W + n * 128 + 8 * c8;
                      const f32x4 s0 = *(const GAS f32x4*)sp, s1 = *(const GAS f32x4*)(sp + 4); x[0] = s0.x; x[1] = s0.y; x[2] = s0.z; x[3] = s0.w; x[4] = s1.x; x[5] = s1.y; x[6] = s1.z; x[7] = s1.w; } }
#pragma unroll
              for (int j = 0; j < 8; ++j) acc[j] += x[j] * wv[kk][j]; }
          v4u o; o.x = pk2(acc[0], acc[1]); o.y = pk2(acc[2], acc[3]); o.z = pk2(acc[4], acc[5]); o.w = pk2(acc[6], acc[7]);
          *(LAS v4u*)(XC + tok * 272 + 16 * c8) = o; } } }
    __syncthreads();
    const int fr = F.lane & 15, fq = F.lane >> 4, w = F.wave;
    f32x4 aR[8], aI[8];
#pragma unroll
    for (int tb = 0; tb < 8; ++tb) { aR[tb] = (f32x4){0.f, 0.f, 0.f, 0.f}; aI[tb] = (f32x4){0.f, 0.f, 0.f, 0.f}; }
#pragma unroll
    for (int ks = 0; ks < 4; ++ks) {
        const bf16x8 br = *(const LAS bf16x8*)(WT + (16 * w + fr) * 272 + (32 * ks + 8 * fq) * 2), bi = *(const LAS bf16x8*)(WT + (128 + 16 * w + fr) * 272 + (32 * ks + 8 * fq) * 2);
#pragma unroll
        for (int tb = 0; tb < 8; ++tb) { const bf16x8 af = *(const LAS bf16x8*)(XC + (16 * tb + fr) * 272 + (32 * ks + 8 * fq) * 2);
            aR[tb] = MFMA32(af, br, aR[tb]); aI[tb] = MFMA32(af, bi, aI[tb]); }
    }
    const int chl = 16 * w + fr, ch = n * 128 + chl;
    const float cc = ((const GAS float*)(F.ws + WS_LRUC))[e_layer * LRU_W + ch], ba = F.inp(I_BA)[e_layer * LRU_W + ch], bx = F.inp(I_BX)[e_layer * LRU_W + ch];
    float H = 0.f, Aprod = 1.f;
    if (MODE == 1) {
        const GAS float* SA = (const GAS float*)(F.ws + WS_LSA) + (size_t)tile_b * NCH * LRU_W + ch; const GAS float* SBm = (const GAS float*)(F.ws + WS_LSB) + (size_t)tile_b * NCH * LRU_W + ch;
        float av[NCH - 1], bv[NCH - 1];
#pragma unroll
        for (int cc = 0; cc < NCH - 1; ++cc) { av[cc] = 1.f; bv[cc] = 0.f; if (cc < tile_c) { av[cc] = SA[(size_t)cc * LRU_W]; bv[cc] = SBm[(size_t)cc * LRU_W]; } }
#pragma unroll
        for (int cc = 0; cc < NCH - 1; ++cc) H = av[cc] * H + bv[cc]; }
    GAS bf16* CAT = (GAS bf16*)(F.ws + WS_CAT);
    bf16 yln[4] = {0, 0, 0, 0};
    if (MODE != 0) {
#pragma unroll
        for (int r = 0; r < 4; ++r) yln[r] = PROJ[(size_t)(row0 + 4 * fq + r) * INW + 5120 + ch]; }
#pragma unroll
    for (int tb = 0; tb < 8; ++tb) {
        bf16 ylc[4];
#pragma unroll
        for (int r = 0; r < 4; ++r) ylc[r] = yln[r];
        if (MODE != 0 && tb < 7) {
#pragma unroll
            for (int r = 0; r < 4; ++r) yln[r] = PROJ[(size_t)(row0 + 16 * (tb + 1) + 4 * fq + r) * INW + 5120 + ch]; }
        float a[4], bt[4];
#pragma unroll
        for (int r = 0; r < 4; ++r) { const int tok = 16 * tb + 4 * fq + r;
            const float rr = sigmoidf_(aR[tb][r] + ba), ii = sigmoidf_(aI[tb][r] + bx), la = -cc * rr;
            a[r] = __builtin_amdgcn_exp2f(1.44269504f * la); const float m2 = 1.0f - a[r] * a[r];
            const float x = bf2f(*(const LAS bf16*)(XC + tok * 272 + 2 * chl));
            bt[r] = sqrtf(fmaxf(m2, 0.f)) * ii * x; }
        if (MODE == 2) {
            const int bb = 32 * tile_c + 4 * tb + fq; float h = F.inp(I_SLRU)[(size_t)(e_layer * DEC_B + bb) * LRU_W + ch];
#pragma unroll
            for (int r = 0; r < 4; ++r) { h = a[r] * h + bt[r]; const size_t row = (size_t)(row0 + 16 * tb + 4 * fq + r);
                const float yl = bf2f(ylc[r]); CAT[row * D + 1024 + ch] = (bf16)f2bf(geluf_(yl) * h); }
            F.out[O_LRUS + (size_t)(e_layer * DEC_B + bb) * LRU_W + ch] = h;
        } else {
            float As = a[0], Bs = bt[0];
#pragma unroll
            for (int r = 1; r < 4; ++r) { Bs = a[r] * Bs + bt[r]; As *= a[r]; }
            float Ai = As, Bi = Bs;
            { const float A1 = __shfl_up(Ai, 16), B1 = __shfl_up(Bi, 16); if (fq >= 1) { Bi = Ai * B1 + Bi; Ai = Ai * A1; } }
            { const float A2 = __shfl_up(Ai, 32), B2 = __shfl_up(Bi, 32); if (fq >= 2) { Bi = Ai * B2 + Bi; Ai = Ai * A2; } }
            float Ae = __shfl_up(Ai, 16), Be = __shfl_up(Bi, 16); if (fq == 0) { Ae = 1.f; Be = 0.f; }
            const float At = __shfl(Ai, 48 + fr), Bt = __shfl(Bi, 48 + fr);
            if (MODE == 1) { float h = Ae * H + Be;
#pragma unroll
                for (int r = 0; r < 4; ++r) { h = a[r] * h + bt[r]; const size_t row = (size_t)(row0 + 16 * tb + 4 * fq + r);
                    const float yl = bf2f(ylc[r]); CAT[row * D + 1024 + ch] = (bf16)f2bf(geluf_(yl) * h); } }
            H = At * H + Bt; Aprod *= At;
        }
    }
    if (MODE == 1 && tile_c == NCH - 1 && fq == 0) F.out[O_LRUP + (size_t)(e_layer * BATCH + tile_b) * LRU_W + ch] = H;
    if (MODE == 0 && fq == 0) { ((GAS float*)(F.ws + WS_LSA))[(size_t)(tile_b * NCH + tile_c) * LRU_W + ch] = Aprod; ((GAS float*)(F.ws + WS_LSB))[(size_t)(tile_b * NCH + tile_c) * LRU_W + ch] = H; }
    if (MODE == 2) {
#pragma unroll 1
        for (int it = 0; it < 24; ++it) { const int item = F.tid + NTHR * it, chx = item & 127, i3 = (item >> 7) % 3, bl = item / 384;
            const int bb = 32 * tile_c + bl; F.out[O_CONVS + ((size_t)(e_layer * DEC_B + bb) * 3 + i3) * LRU_W + n * 128 + chx] = bf2f(PROJ[(size_t)(MP + bb * 4 + 1 + i3) * INW + 4096 + n * 128 + chx]); }
    } else if (MODE == 1 && tile_c == NCH - 1) {
        if (F.tid < 384) { const int chx = F.tid & 127, i3 = F.tid >> 7;
            F.out[O_CONVP + ((size_t)(e_layer * BATCH + tile_b) * 3 + i3) * LRU_W + n * 128 + chx] = bf2f(PROJ[(size_t)(tile_b * SEQ + SEQ - 3 + i3) * INW + 4096 + n * 128 + chx]); }
    }
}
template <int MODE>
__device__ __forceinline__ void s5_wave_unit(const Frame& F, int o_layer, int pb, int pc, int g) {
    LAS float* BU = (LAS float*)(F.lds + F.wave * 12800);
    LAS unsigned char* SS = F.lds + F.wave * 12800 + 8448;
    const int lane = F.lane, fr = lane & 15, fq = lane >> 4;
    const GAS bf16* XN = (const GAS bf16*)(F.ws + WS_XN); GAS bf16* CAT = (GAS bf16*)(F.ws + WS_CAT);
    const GAS bf16* BB = (const GAS bf16*)(F.ws + WS_S5BB) + (size_t)(o_layer * SG + g) * 128 * 16;
    const GAS bf16* CM = (const GAS bf16*)(F.ws + WS_S5CM) + (size_t)(o_layer * SG + g) * 16 * 128;
    bf16x4 bb[8];
#pragma unroll
    for (int nb = 0; nb < 8; ++nb) bb[nb] = __builtin_bit_cast(bf16x4, *(const GAS v2u*)(BB + (16 * nb + fr) * 16 + 4 * fq));
    bf16x8 cm[4]; f32x4 dd = (f32x4){0.f, 0.f, 0.f, 0.f};
    if (MODE != 0) {
#pragma unroll
        for (int ks = 0; ks < 4; ++ks) cm[ks] = __builtin_bit_cast(bf16x8, *(const GAS v4u*)(CM + fr * 128 + 32 * ks + 8 * fq));
        dd = *(const GAS f32x4*)(F.inp(I_SD) + (size_t)o_layer * D + 16 * g + 4 * fq); }
    const f32x4 ab = *(const GAS f32x4*)((const GAS float*)(F.ws + WS_S5AB) + (size_t)((o_layer * SG + g) * SP + lane) * 4);
    const float ar = ab.x, ai = ab.y;
    float sr = 0.f, si = 0.f;
    GAS float* LOC = (GAS float*)(F.ws + WS_S5LOC);
    if (MODE == 1) {
        const float a8r = ab.z, a8i = ab.w; const GAS f32x2* lp = (const GAS f32x2*)(LOC + ((size_t)pb * NCH * 8192 + g * SP + lane) * 2);
        f32x2 lv[NCH - 1];
#pragma unroll
        for (int cc = 0; cc < NCH - 1; ++cc) { lv[cc] = (f32x2){0.f, 0.f}; if (cc < pc) lv[cc] = lp[(size_t)cc * 8192]; }
#pragma unroll
        for (int cc = 0; cc < NCH - 1; ++cc) if (cc < pc) { const float nr = a8r * sr - a8i * si + lv[cc].x, ni = a8r * si + a8i * sr + lv[cc].y; sr = nr; si = ni; } }
    constexpr int nsub = MODE == 2 ? 1 : 8;
    const int rowbase = MODE == 2 ? MP + 16 * pc : pb * SEQ + CH * pc;
    v2u uall[nsub], oall[nsub];
#pragma unroll
    for (int sub = 0; sub < nsub; ++sub) uall[sub] = *(const GAS v2u*)(XN + (size_t)(rowbase + 16 * sub + fr) * D + 16 * g + 4 * fq);
#pragma unroll
    for (int sub = 0; sub < nsub; ++sub) {
        const int r0 = rowbase + 16 * sub;
        const v2u uraw = uall[sub];
        const bf16x4 uf = __builtin_bit_cast(bf16x4, uraw);
#pragma unroll
        for (int nb = 0; nb < 8; ++nb) { const f32x4 d = MFMA16(bb[nb], uf, ((f32x4){0.f, 0.f, 0.f, 0.f}));
            *(LAS f32x4*)(BU + fr * 132 + 16 * nb + 4 * fq) = d; }
        float isr[4], isi[4];
        if (MODE == 2) {
#pragma unroll
            for (int q = 0; q < 4; ++q) { const size_t si0 = ((size_t)(o_layer * DEC_B + 4 * pc + q) * SG + g) * SP + lane; isr[q] = F.inp(I_SSRE)[si0]; isi[q] = F.inp(I_SSIM)[si0]; } }
        float br[16], bi[16];
#pragma unroll
        for (int t = 0; t < 16; ++t) { const f32x2 bv = *(const LAS f32x2*)(BU + t * 132 + 2 * lane); br[t] = bv.x; bi[t] = bv.y; }
#pragma unroll
        for (int t = 0; t < 16; ++t) {
            if (MODE == 2 && (t & 3) == 0) { sr = isr[t >> 2]; si = isi[t >> 2]; }
            const float nr = ar * sr - ai * si + br[t], ni = ar * si + ai * sr + bi[t]; sr = nr; si = ni;
            if (MODE != 0) *(LAS u32a*)(SS + t * 272 + 4 * lane) = pk2(sr, si);
            if (MODE == 2 && (t & 3) == 3) { const int bbt = 4 * pc + (t >> 2); const size_t so = ((size_t)(o_layer * DEC_B + bbt) * SG + g) * SP + lane; F.out[O_SRES + so] = sr; F.out[O_SIMS + so] = si; }
        }
        if (MODE != 0) {
            f32x4 y = (f32x4){0.f, 0.f, 0.f, 0.f};
#pragma unroll
            for (int ks = 0; ks < 4; ++ks) { const bf16x8 sf = *(const LAS bf16x8*)(SS + fr * 272 + (32 * ks + 8 * fq) * 2); y = MFMA32(cm[ks], sf, y); }
            const float u0 = bflo(uraw.x), u1 = bfhi(uraw.x), u2 = bflo(uraw.y), u3 = bfhi(uraw.y);
            v2u o; o.x = pk2(geluf_(y[0] + dd.x * u0), geluf_(y[1] + dd.y * u1)); o.y = pk2(geluf_(y[2] + dd.z * u2), geluf_(y[3] + dd.w * u3));
            oall[sub] = o;
        }
    }
    if (MODE != 0) {
#pragma unroll
        for (int sub = 0; sub < nsub; ++sub) *(GAS v2u*)(CAT + (size_t)(rowbase + 16 * sub + fr) * D + 16 * g + 4 * fq) = oall[sub]; }
    if (MODE == 0) *(GAS f32x2*)(LOC + ((size_t)(pb * NCH + pc) * 8192 + g * SP + lane) * 2) = (f32x2){sr, si};
    if (MODE == 1 && pc == NCH - 1) { const size_t so = (size_t)(o_layer * BATCH + pb) * 8192 + g * SP + lane; F.out[O_SREP + so] = sr; F.out[O_SIMP + so] = si; }
}

#define SWZX(x, pat) __builtin_bit_cast(float, __builtin_amdgcn_ds_swizzle(__builtin_bit_cast(int, (x)), (pat)))
__device__ __forceinline__ void s5_end_units(const Frame& F, int o_layer, int g, int half, int piece0, int pstep) {
    const int lane = F.lane, fr = lane & 15, fq = lane >> 4;
    const GAS bf16* XN = (const GAS bf16*)(F.ws + WS_XN);
    const GAS v2u* T = (const GAS v2u*)(F.ws + WS_S5PW) + ((size_t)(o_layer * SG + g) * 64 + 4 * half) * 64 + lane;
    bf16x4 tab[8][4];
#pragma unroll
    for (int sub = 0; sub < 8; ++sub)
#pragma unroll
        for (int mb = 0; mb < 4; ++mb) tab[sub][mb] = __builtin_bit_cast(bf16x4, T[(size_t)(sub * 8 + mb) * 64]);
    const GAS bf16* BB = (const GAS bf16*)(F.ws + WS_S5BB) + (size_t)(o_layer * SG + g) * 128 * 16;
    float bre[8], bim[8];
#pragma unroll
    for (int j = 0; j < 8; ++j) { const int p = 8 * (4 * half + (j >> 1)) + 2 * fq + (j & 1);
        bre[j] = __builtin_bit_cast(float, (unsigned)BB[(2 * p) * 16 + fr] << 16); bim[j] = __builtin_bit_cast(float, (unsigned)BB[(2 * p + 1) * 16 + fr] << 16); }
    v2u idw; { const int d = fr - 4 * fq; idw.x = d == 0 ? 0x3F80u : d == 1 ? 0x3F800000u : 0u; idw.y = d == 2 ? 0x3F80u : d == 3 ? 0x3F800000u : 0u; }
    const bf16x4 ident = __builtin_bit_cast(bf16x4, idw);
    GAS float* LOC = (GAS float*)(F.ws + WS_S5LOC);
    v2u ub[3][8];
#define S5E_LOADU(buf, pcx) { const int rb_ = ((pcx) >> 4) * SEQ + CH * ((pcx) & 15); _Pragma("unroll") for (int sub = 0; sub < 8; ++sub) buf[sub] = *(const GAS v2u*)(XN + (size_t)(rb_ + 16 * sub + fr) * D + 16 * g + 4 * fq); }
    S5E_LOADU(ub[0], piece0); S5E_LOADU(ub[1], piece0 + pstep);
#pragma unroll
    for (int it = 0; it < 8; ++it) { const int pc = piece0 + pstep * it;
        if (it + 2 < 8) S5E_LOADU(ub[(it + 2) % 3], piece0 + pstep * (it + 2));
        v2u (&uall)[8] = ub[it % 3];
        f32x4 acc[4];
#pragma unroll
        for (int mb = 0; mb < 4; ++mb) acc[mb] = (f32x4){0.f, 0.f, 0.f, 0.f};
#pragma unroll
        for (int sub = 0; sub < 8; ++sub) {
            const f32x4 d = MFMA16(__builtin_bit_cast(bf16x4, uall[sub]), ident, ((f32x4){0.f, 0.f, 0.f, 0.f}));
            v2u utw; utw.x = pk2(d[0], d[1]); utw.y = pk2(d[2], d[3]);
            const bf16x4 ut = __builtin_bit_cast(bf16x4, utw);
#pragma unroll
            for (int mb = 0; mb < 4; ++mb) acc[mb] = MFMA16(tab[sub][mb], ut, acc[mb]);
        }
        float v[16];
#pragma unroll
        for (int j = 0; j < 8; ++j) { const float wr = acc[j >> 1][2 * (j & 1)], wi = acc[j >> 1][2 * (j & 1) + 1];
            v[2 * j] = bre[j] * wr - bim[j] * wi; v[2 * j + 1] = bre[j] * wi + bim[j] * wr; }
#pragma unroll
        for (int i = 0; i < 8; ++i) { const bool up = (fr & 8) != 0; const float send = up ? v[i] : v[8 + i], keep = up ? v[8 + i] : v[i]; v[i] = keep + SWZX(send, 0x201F); }
#pragma unroll
        for (int i = 0; i < 4; ++i) { const bool up = (fr & 4) != 0; const float send = up ? v[i] : v[4 + i], keep = up ? v[4 + i] : v[i]; v[i] = keep + SWZX(send, 0x101F); }
#pragma unroll
        for (int i = 0; i < 2; ++i) { const bool up = (fr & 2) != 0; const float send = up ? v[i] : v[2 + i], keep = up ? v[2 + i] : v[i]; v[i] = keep + SWZX(send, 0x081F); }
        const float sre = v[0] + SWZX(v[0], 0x041F), sim = v[1] + SWZX(v[1], 0x041F);
        const int j = fr >> 1, p = 8 * (4 * half + (j >> 1)) + 2 * fq + (j & 1);
        if ((fr & 1) == 0) *(GAS f32x2*)(LOC + ((size_t)pc * 8192 + g * SP + p) * 2) = (f32x2){sre, sim};
    }
}
#ifndef RS_PROBE_MODE
#define RS_PROBE_MODE 0
#endif
#ifndef REPU_RETS
#define REPU_RETS 0
#endif
#ifndef REPU_LRU0
#define REPU_LRU0 0
#endif
#ifndef REPU_RSCAN
#define REPU_RSCAN 0
#endif
#ifndef REP_P0
#define REP_P0 0
#endif
#ifndef REP_G1
#define REP_G1 0
#endif
#ifndef REP_MIXA
#define REP_MIXA 0
#endif
#ifndef REP_MIXC
#define REP_MIXC 0
#endif
#ifndef REP_S5A
#define REP_S5A 0
#endif
#ifndef REP_S5C
#define REP_S5C 0
#endif
#ifndef REP_G4
#define REP_G4 0
#endif
#ifndef REP_RMS
#define REP_RMS 0
#endif
#ifdef SKIP_P0
#define DO_P0 0
#else
#define DO_P0 1
#endif
#ifdef SKIP_RETA
#define DO_RETA 0
#else
#define DO_RETA 1
#endif
#ifdef SKIP_LRU0
#define DO_LRU0 0
#else
#define DO_LRU0 1
#endif
#ifdef SKIP_RETS
#define DO_RETS 0
#else
#define DO_RETS 1
#endif
#ifdef SKIP_LRU2
#define DO_LRU2 0
#else
#define DO_LRU2 1
#endif
#ifdef SKIP_BPH
#define DO_BPH 0
#else
#define DO_BPH 1
#endif
#ifdef SKIP_RETC
#define DO_RETC 0
#else
#define DO_RETC 1
#endif
#ifdef SKIP_LRU1
#define DO_LRU1 0
#else
#define DO_LRU1 1
#endif
#ifdef SKIP_S50
#define DO_S50 0
#else
#define DO_S50 1
#endif
#ifdef SKIP_S52
#define DO_S52 0
#else
#define DO_S52 1
#endif
#ifdef SKIP_S51
#define DO_S51 0
#else
#define DO_S51 1
#endif
#ifdef SKIP_S5B
#define DO_S5B 0
#else
#define DO_S5B 1
#endif
#ifdef SKIP_G1
#define DO_G1 0
#else
#define DO_G1 1
#endif
#ifdef SKIP_G2
#define DO_G2 0
#else
#define DO_G2 1
#endif
#ifdef SKIP_G3
#define DO_G3 0
#else
#define DO_G3 1
#endif
#ifdef SKIP_G4
#define DO_G4 0
#else
#define DO_G4 1
#endif
#ifdef SKIP_G5
#define DO_G5 0
#else
#define DO_G5 1
#endif
#ifdef SKIP_RMS
#define DO_RMS 0
#else
#define DO_RMS 1
#endif
struct Args { const float* in[N_IN]; float* out; unsigned char* ws; int ph_lo, ph_hi; };
static_assert(sizeof(Args) == (N_IN + 2) * 8 + 8, "Args has no padding");

__global__ void __launch_bounds__(NTHR, 2) fwd_kernel(Args args) {
    extern __shared__ __attribute__((aligned(16))) unsigned char lds_raw[];
    Frame F;
    F.lds = (LAS unsigned char*)lds_raw;
    F.tid = threadIdx.x; F.lane = F.tid & 63; F.wave = __builtin_amdgcn_readfirstlane(F.tid >> 6);
    F.G = gridDim.x; F.bid = blockIdx.x;
    F.out = (GAS float*)args.out; F.ws = (GAS unsigned char*)args.ws;
    volatile LAS unsigned* MISC = (volatile LAS unsigned*)(F.lds + MISC_OFF);
    for (int u = F.tid; u < (LDS_BYTES - MISC_OFF) / 4; u += NTHR) MISC[u] = 0u;
    __syncthreads();
    const int lo = args.ph_lo, hi = args.ph_hi;
    unsigned* barw = (unsigned*)(F.ws + WS_CTL) + CW_BAR;
    XcdBarrier bar; bar.bar = barw; bar.x = 0; bar.st = nullptr;
    if (hi - lo > 1) bar = xcd_barrier_post(barw, MISC + 8);
#define IN(k) (lo <= (k) && (k) < hi)
#ifndef REP_BAR
#define REP_BAR 0
#endif
#define SEAM(k) do { if (IN(k) && IN((k) + 1)) { for (int rb = 0; rb <= REP_BAR; ++rb) xcd_barrier(bar, F.tid); } } while (0)
#define LAUNDER() do { asm volatile("" : "+s"(F.ws), "+s"(F.out), "+s"(F.bid), "+v"(F.tid), "+v"(F.lane)); F.wave = __builtin_amdgcn_readfirstlane(F.tid >> 6); } while (0)
    const int gw = F.bid * NWAVES + F.wave, NGW = F.G * NWAVES;

    if (DO_P0 && IN(0)) { for (int rep = 0; rep <= REP_P0; ++rep) { LAUNDER(); p0_prologue(F); } }

    SEAM(0);

#pragma unroll 1
    for (int layer = 0; layer < 4; ++layer) {
        const int base = 1 + 9 * layer, el = layer >> 1;
        if (!(layer & 1)) {
            if (IN(base + 0)) { LAUNDER();
                pg8::Gemm g{(const GAS bf16*)(F.ws + WS_XN), (const GAS bf16*)(F.ws + WS_WIN + el * SZ_WIN), M, INW, D}; pg8::StaticOrder S; S.init(M, INW, F.G, F.bid, D / 64);
                pg8::EpiStoreBf16 E{(GAS bf16*)(F.ws + WS_PROJ), INW};

                for (int rep = 0; rep <= REP_G1; ++rep) { if (DO_G1) pg8::gemm_phase<pg8::EpiStoreBf16, pg8::StaticOrder, true, true>(F.lds, g, S, E, F.tid); }
                LAUNDER(); if (el == 0) conv_in_tail(F, CV_E0, CV_E3, (M / 256) * (INW / 256) - 3 * F.G); else conv_in_tail(F, CV_E7, CV_E10, (M / 256) * (INW / 256) - 3 * F.G);

            }
            SEAM(base + 0);
            if (IN(base + 1)) for (int rep = 0; rep <= REP_MIXA; ++rep) { LAUNDER();
#pragma unroll 1
                for (int st = 0; st < 2; ++st) {
                    LAUNDER();
                    if ((st ^ (F.bid & 1)) == 0) {
                        if (DO_RETA)
#pragma unroll 1
                        for (int rp = 0; rp <= REPU_RSCAN; ++rp) for (int u0 = F.bid; u0 < 256; u0 += F.G) { const int u = ((u0 & 7) << 5) | (u0 >> 3); ret_scan_unit(F, el, u >> 6, (u >> 4) & 3, (u >> 2) & 3, u & 3); }
                        LAUNDER();
                        if (DO_LRU0)
#pragma unroll 1
                        for (int rp = 0; rp <= REPU_LRU0; ++rp) for (int u = F.bid; u < 512; u += F.G) lru_unit<0>(F, el, u >> 7, (u >> 3) & 15, u & 7, u == F.bid || (F.G & 7) != 0);
                    } else {
                        if (DO_RETS)
#pragma unroll 1
                        for (int rp = 0; rp <= REPU_RETS; ++rp) for (int u = F.bid; u < 512; u += F.G) { if (rp < REPU_RETS) ret_s_unit<RS_PROBE_MODE>(F, el, u >> 2, u & 3); else ret_s_unit<0>(F, el, u >> 2, u & 3); }
                        LAUNDER();
                        if (DO_LRU2)
#pragma unroll 1
                        for (int u = F.bid; u < 32; u += F.G) lru_unit<2>(F, el, 0, u >> 3, u & 7, true);
                    }
                }
            }
            SEAM(base + 1);

            if (IN(base + 3)) for (int rep = 0; rep <= REP_MIXC; ++rep) { LAUNDER();
                LAUNDER();
                if (DO_RETC)
#pragma unroll 1
                for (int u = F.bid; u < 256; u += F.G) ret_c_unit(F, u >> 6, (u >> 4) & 3, u & 15);

                LAUNDER();

                if (DO_LRU1)
#pragma unroll 1
                for (int u = F.bid; u < 512; u += F.G) lru_unit<1>(F, el, u >> 7, (u >> 3) & 15, u & 7, u == F.bid || (F.G & 7) != 0);

            }
            SEAM(base + 3);
            if (IN(base + 4)) { LAUNDER();
                pg8::Gemm g{(const GAS bf16*)(F.ws + WS_CAT), (const GAS bf16*)(F.ws + WS_WOUT + el * SZ_WOUT), M, D, D}; pg8::TailOrder S; S.init(MP, MS / 256, D, F.G, F.bid, D / 64, S_OUT);
                pg8::EpiResid E{(GAS float*)(F.ws + WS_X), D, (GAS float*)(F.ws + WS_SLAB), MP, MS};

            if (DO_G2) pg8::gemm_phase<pg8::EpiResid, pg8::TailOrder, true, true>(F.lds, g, S, E, F.tid);
            LAUNDER(); if (el == 0) conv_in_tail(F, CV_E3, CV_T2E, (MS / 256) * (D / 256) * S_OUT); else conv_in_tail(F, CV_E10, CV_T7E, (MS / 256) * (D / 256) * S_OUT);
#ifdef REP_G2
            { pg8::EpiResid E2{(GAS float*)(F.ws + WS_PROJ), D, (GAS float*)(F.ws + WS_SLAB), MP, MS}; for (int rep = 0; rep < REP_G2; ++rep) pg8::gemm_phase<pg8::EpiResid, pg8::TailOrder, true, true>(F.lds, g, S, E2, F.tid); }
#endif

            }
            SEAM(base + 4);
        } else {
            if (IN(base + 1)) for (int rep = 0; rep <= REP_S5A; ++rep) { LAUNDER();
                LAUNDER();
                if (DO_S50)
#pragma unroll 1
                for (int wu = gw; wu < 2048; wu += NGW) s5_end_units(F, el, wu & 127, (wu >> 7) & 1, wu >> 8, 8);

                LAUNDER();

                if (DO_S52)
#pragma unroll 1
                for (int u = gw; u < 32 * SG; u += NGW) s5_wave_unit<2>(F, el, 0, u >> 7, u & 127);

            }
            SEAM(base + 1);
            if (IN(base + 3)) for (int rep = 0; rep <= REP_S5C; ++rep) { LAUNDER();
                LAUNDER();
                if (DO_S51)
#pragma unroll 1
                for (int u = gw; u < BATCH * NCH * SG; u += NGW) s5_wave_unit<1>(F, el, u >> 11, (u >> 7) & 15, u & 127);

            }
            SEAM(base + 3);
            if (IN(base + 4)) { LAUNDER();
                pg8::Gemm g{(const GAS bf16*)(F.ws + WS_CAT), (const GAS bf16*)(F.ws + WS_WGLU + el * SZ_WGLU), M, 2 * D, D}; pg8::TailOrder S; S.init(MP, MS / 256, 2 * D, F.G, F.bid, D / 64, S_GLU);
                pg8::EpiGluResid E{(GAS float*)(F.ws + WS_X), D, F.inp(I_BGLU) + (size_t)el * 2 * D, D, (GAS float*)(F.ws + WS_SLAB), MP, MS};

                if (DO_G3) pg8::gemm_phase<pg8::EpiGluResid, pg8::TailOrder, true, true>(F.lds, g, S, E, F.tid);

            }
            SEAM(base + 4);
        }
        if (DO_RMS && IN(base + 5)) { LAUNDER(); if (layer & 1) rms_phase(F, 0, nullptr, 2, S_GLU, F.inp(I_BGLU) + (size_t)el * 2 * D); else rms_phase(F, 0, nullptr, 1, S_OUT, nullptr); }
        SEAM(base + 5);
        if (IN(base + 6)) { LAUNDER();
            pg8::Gemm g{(const GAS bf16*)(F.ws + WS_XN), (const GAS bf16*)(F.ws + WS_WGU + layer * SZ_WGU), M, 2 * FF, D}; pg8::StaticOrder S; S.init(M, 2 * FF, F.G, F.bid, D / 64);
            pg8::EpiSwiglu E{(GAS bf16*)(F.ws + WS_H), FF};

            for (int rep = 0; rep <= REP_G4; ++rep) { if (DO_G4) pg8::gemm_phase<pg8::EpiSwiglu, pg8::StaticOrder, true, true>(F.lds, g, S, E, F.tid); }
            LAUNDER(); { const int nb = (M / 256) * (2 * FF / 256) - 5 * F.G;
              if (layer == 0) conv_in_tail(F, CV_T2E, CV_T3E, nb); else if (layer == 1) conv_in_tail(F, CV_E6, CV_T5E, nb); else if (layer == 2) conv_in_tail(F, CV_T7E, CV_T8E, nb); }

        }
        SEAM(base + 6);
        if (IN(base + 7)) { LAUNDER();
            pg8::Gemm g{(const GAS bf16*)(F.ws + WS_H), (const GAS bf16*)(F.ws + WS_WDN + layer * SZ_WDN), M, D, FF}; pg8::TailOrder S; S.init(MP, MS / 256, D, F.G, F.bid, FF / 64, S_DN);
            pg8::EpiResid E{(GAS float*)(F.ws + WS_X), D, (GAS float*)(F.ws + WS_SLAB), MP, MS};

            if (DO_G5) pg8::gemm_phase<pg8::EpiResid, pg8::TailOrder, true, true>(F.lds, g, S, E, F.tid);
            LAUNDER(); { const int nb = (MS / 256) * (D / 256) * S_DN;
              if (layer == 0) conv_in_tail(F, CV_T3E, CV_T4E, nb); else if (layer == 1) conv_in_tail(F, CV_T5E, CV_E7, nb); else if (layer == 2) conv_in_tail(F, CV_T8E, CV_T9E, nb); }
#ifdef REP_G5
            { pg8::EpiResid E2{(GAS float*)(F.ws + WS_PROJ), D, (GAS float*)(F.ws + WS_SLAB), MP, MS}; for (int rep = 0; rep < REP_G5; ++rep) pg8::gemm_phase<pg8::EpiResid, pg8::TailOrder, true, true>(F.lds, g, S, E2, F.tid); }
#endif

        }
        SEAM(base + 7);
        if (DO_RMS && IN(base + 8)) { LAUNDER();
            if (layer == 3) { rms_phase(F, 2, F.inp(I_NFIN), 1, S_DN, nullptr); }
            else if (!(layer & 1)) { rms_phase(F, 1, F.inp(I_NMO) + (size_t)el * D, 1, S_DN, nullptr); }
            else { rms_phase(F, 0, nullptr, 1, S_DN, nullptr); }
        }
        if (layer < 3) SEAM(base + 8);
    }
#undef IN
#undef SEAM
#undef LAUNDER
}

extern "C" void kernel_launch(void* const* d_in, const int* in_sizes, int n_in, void* d_out, int out_size, void* d_ws, size_t ws_size, hipStream_t stream) {
    static int grid = 0;
    if (grid == 0) {
        if (n_in != N_IN || (size_t)out_size != O_END || ws_size < WS_END) { fprintf(stderr, "kernel_launch: unexpected sizes: n_in %d out %d ws %zu (need %d, %zu, >= %zu)\n", n_in, out_size, ws_size, (int)N_IN, (size_t)O_END, (size_t)WS_END); grid = -1; return; }
        int dev = 0, cus = 0, per_cu = 0;
        if (hipGetDevice(&dev) != hipSuccess || hipDeviceGetAttribute(&cus, hipDeviceAttributeMultiprocessorCount, dev) != hipSuccess) { grid = -1; return; }
        if (hipFuncSetAttribute((const void*)fwd_kernel, hipFuncAttributeMaxDynamicSharedMemorySize, LDS_BYTES) != hipSuccess) { fprintf(stderr, "kernel_launch: hipFuncSetAttribute failed\n"); grid = -1; return; }
        if (hipOccupancyMaxActiveBlocksPerMultiprocessor(&per_cu, (const void*)fwd_kernel, NTHR, LDS_BYTES) != hipSuccess || per_cu < 1) { fprintf(stderr, "kernel_launch: occupancy query says %d blocks per CU\n", per_cu); (void)hipGetLastError(); grid = -1; return; }
        grid = cus;
    }
    if (grid < 0) return;
    if (hipMemsetAsync((char*)d_ws + WS_CTL, 0, CTL_ZERO_BYTES, stream) != hipSuccess) return;
    Args a{};
    for (int i = 0; i < N_IN; ++i) a.in[i] = (const float*)d_in[i];
    a.out = (float*)d_out; a.ws = (unsigned char*)d_ws;
#if MK_ONE_LAUNCH
    a.ph_lo = 0; a.ph_hi = NPHASE;
    hipLaunchKernelGGL(fwd_kernel, dim3(grid), dim3(NTHR), LDS_BYTES, stream, a);
#else
    for (int ph = 0; ph < NPHASE; ++ph) {
        if (ph >= 1 && ((ph - 1) % 9) == 0 && (((ph - 1) / 9) & 1)) continue;
        if (ph >= 1 && ((ph - 1) % 9) == 2) continue;
        a.ph_lo = ph; a.ph_hi = ph + 1;
        hipLaunchKernelGGL(fwd_kernel, dim3(grid), dim3(NTHR), LDS_BYTES, stream, a);
    }
#endif
}
```

```cpp
#include <hip/hip_runtime.h>
#include <cstdio>
#include <cstdint>
#define MK_ONE_LAUNCH 1
namespace pg8 {
#define PG8_LAS __attribute__((address_space(3)))
#define PG8_GAS __attribute__((address_space(1)))
typedef unsigned short __attribute__((may_alias)) bf16_t;
typedef short bf16x8 __attribute__((ext_vector_type(8), may_alias));
typedef float f32x4 __attribute__((ext_vector_type(4), may_alias));
typedef unsigned u32x4 __attribute__((ext_vector_type(4), may_alias));
constexpr int BM = 256, BK = 64, HALF = 128, HTB = HALF * BK * 2  , STAGE_BYTES = 8 * HTB, NXCD = 8, WGM = 8;

__host__ __device__ __forceinline__ int lds_byte(int r, int c) { const int st = (r >> 4) * 2 + (c >> 5), rr = r & 15, cc = c & 31, ob = rr * 64 + cc * 2; return st * 1024 + (ob ^ (((ob >> 9) & 1) << 5)); }
__host__ __device__ __forceinline__ void stage_rc(int b, int& R, int& C) { const int st = b / 1024, sb = b % 1024, swz = sb ^ (((sb >> 9) & 1) << 5); R = (st >> 1) * 16 + swz / 64; C = (st & 1) * 32 + (swz % 64) / 2; }
__host__ __device__ __forceinline__ int perm32(int rho) { const int n = rho >> 4, i = rho & 15; return 8 * (i >> 2) + 4 * n + (i & 3); }

struct Unit { int pm, pn, k0, nt, slice; };
struct Gemm { const PG8_GAS bf16_t* A; const PG8_GAS bf16_t* Bt; int M, N, K; };

struct StaticOrder {
    int nM, nN, nwg, G, c, ntk;
    __host__ __device__ void init(int M, int N, int G_, int c_, int ntk_) { nM = M / BM; nN = N / BM; nwg = nM * nN; G = G_; c = c_; ntk = ntk_; }
    __host__ __device__ bool next(int i, Unit& u) const {
        const long L = (long)i * G + c; if (L >= nwg) return false;
        int wgid = (int)L; { const int q = nwg / NXCD, r = nwg % NXCD, xcd = wgid % NXCD, off = wgid / NXCD; wgid = (xcd < r ? xcd * (q + 1) : r * (q + 1) + (xcd - r) * q) + off; }
        const int nig = WGM * nN, gid = wgid / nig, fm = gid * WGM, gsz = (nM - fm) < WGM ? (nM - fm) : WGM;
        u.pm = fm + ((wgid % nig) % gsz); u.pn = (wgid % nig) / gsz; u.k0 = 0; u.nt = ntk; u.slice = -1; return true;
    }
    __device__ __forceinline__ void a_ready(const Unit&) const {}
    __device__ __forceinline__ void done(const Unit&) const {}
};

struct TailOrder {
    StaticOrder main; int nN, S, nts, ntail, pm0;
    __host__ __device__ void init(int Mmain, int ntail_m, int N, int G_, int c_, int ntk, int S_) { main.init(Mmain, N, G_, c_, ntk); nN = N / BM; S = S_; nts = ntk / S_; ntail = ntail_m * nN * S_; pm0 = Mmain / BM; }
    __host__ __device__ bool next(int i, Unit& u) const {
        const long L = (long)i * main.G + main.c;
        if (L < main.nwg) return main.next(i, u);
        const int j = (int)(L - main.nwg); if (j >= ntail) return false;
        const int tile = j / S, sl = j - tile * S;
        u.pm = pm0 + (tile & 1); u.pn = tile >> 1; u.k0 = sl * nts * BK; u.nt = nts; u.slice = sl; return true;
    }
    __device__ __forceinline__ void a_ready(const Unit&) const {}
    __device__ __forceinline__ void done(const Unit&) const {}
};
typedef __bf16 bf16v2_ __attribute__((ext_vector_type(2))); typedef float f32v2_ __attribute__((ext_vector_type(2)));
__device__ __forceinline__ unsigned cvt_pk_bf16(float lo, float hi) { const f32v2_ v = {lo, hi}; return __builtin_bit_cast(unsigned, __builtin_convertvector(v, bf16v2_)); }
typedef float f32x2 __attribute__((ext_vector_type(2)));
__device__ __forceinline__ float fast_sigmoid(float x) { return __builtin_amdgcn_rcpf(1.0f + __builtin_amdgcn_exp2f(-1.44269504f * x)); }
struct EpiStoreBf16 {
    static constexpr bool PERM = true, AFTER_DRAIN = false;
    PG8_GAS bf16_t* O; int ldc;
    __device__ __forceinline__ void operator()(const f32x4 (&acc)[2][2][4][2], const Unit& u, int wr, int wc, int fr, int fq) const {
        const int row0 = u.pm * BM + wr * 64 + fr, col0 = u.pn * BM + wc * 32 + 8 * fq;
#pragma unroll
        for (int ai = 0; ai < 2; ++ai)
#pragma unroll
            for (int m = 0; m < 4; ++m) { PG8_GAS bf16_t* rowp = O + (size_t)(row0 + ai * HALF + m * 16) * ldc + col0;
#pragma unroll
                for (int bj = 0; bj < 2; ++bj) { const f32x4 v0 = acc[ai][bj][m][0], v1 = acc[ai][bj][m][1];
                    u32x4 w; w.x = cvt_pk_bf16(v0[0], v0[1]); w.y = cvt_pk_bf16(v0[2], v0[3]); w.z = cvt_pk_bf16(v1[0], v1[1]); w.w = cvt_pk_bf16(v1[2], v1[3]);
                    *(PG8_GAS u32x4*)(rowp + bj * HALF) = w; } }
    }
};
struct EpiResid {
    static constexpr bool PERM = false, AFTER_DRAIN = false;
    PG8_GAS float* X; int ldc; PG8_GAS float* slab; int row_base, slab_rows;
    __device__ __forceinline__ void operator()(const f32x4 (&acc)[2][2][4][2], const Unit& u, int wr, int wc, int fr, int fq) const {
        const int row0 = u.pm * BM + wr * 64 + fr, col0 = u.pn * BM + wc * 32 + 4 * fq;
        if (u.slice >= 0) {
            PG8_GAS float* sb = slab + ((size_t)u.slice * slab_rows + (row0 - row_base)) * ldc + col0;
#pragma unroll
            for (int ai = 0; ai < 2; ++ai)
#pragma unroll
                for (int m = 0; m < 4; ++m) { PG8_GAS float* rowp = sb + (size_t)(ai * HALF + m * 16) * ldc;
#pragma unroll
                    for (int bj = 0; bj < 2; ++bj)
#pragma unroll
                        for (int n = 0; n < 2; ++n) *(PG8_GAS f32x4*)(rowp + bj * HALF + n * 16) = acc[ai][bj][m][n]; }
            return;
        }
#pragma unroll
        for (int ai = 0; ai < 2; ++ai)
#pragma unroll
            for (int m = 0; m < 4; ++m) { PG8_GAS float* rowp = X + (size_t)(row0 + ai * HALF + m * 16) * ldc + col0;
                f32x4 b[2][2];
#pragma unroll
                for (int bj = 0; bj < 2; ++bj)
#pragma unroll
                    for (int n = 0; n < 2; ++n) b[bj][n] = *(const PG8_GAS f32x4*)(rowp + bj * HALF + n * 16);
#pragma unroll
                for (int bj = 0; bj < 2; ++bj)
#pragma unroll
                    for (int n = 0; n < 2; ++n) *(PG8_GAS f32x4*)(rowp + bj * HALF + n * 16) = b[bj][n] + acc[ai][bj][m][n];
                if (m == 3) asm volatile("" ::: "memory"); }
    }
};
struct EpiSwiglu {
    static constexpr bool PERM = true, AFTER_DRAIN = false;
    PG8_GAS bf16_t* H; int ldh;
    __device__ __forceinline__ void operator()(const f32x4 (&acc)[2][2][4][2], const Unit& u, int wr, int wc, int fr, int fq) const {
        const int row0 = u.pm * BM + wr * 64 + fr, col0 = u.pn * HALF + wc * 32 + 8 * fq;
#pragma unroll
        for (int ai = 0; ai < 2; ++ai)
#pragma unroll
            for (int m = 0; m < 4; ++m) { PG8_GAS bf16_t* rowp = H + (size_t)(row0 + ai * HALF + m * 16) * ldh + col0;
                f32x4 v[2];
#pragma unroll
                for (int n = 0; n < 2; ++n) { const f32x4 g = acc[ai][0][m][n], uu = acc[ai][1][m][n];
#pragma unroll
                    for (int j = 0; j < 4; ++j) v[n][j] = g[j] * fast_sigmoid(g[j]) * uu[j]; }
                u32x4 w; w.x = cvt_pk_bf16(v[0][0], v[0][1]); w.y = cvt_pk_bf16(v[0][2], v[0][3]); w.z = cvt_pk_bf16(v[1][0], v[1][1]); w.w = cvt_pk_bf16(v[1][2], v[1][3]);
                *(PG8_GAS u32x4*)rowp = w; }
    }
};
struct EpiGluResid {
    static constexpr bool PERM = false, AFTER_DRAIN = false;
    PG8_GAS float* X; int ldc; const PG8_GAS float* bias; int nhalf; PG8_GAS float* slab; int row_base, slab_rows;
    __device__ __forceinline__ void operator()(const f32x4 (&acc)[2][2][4][2], const Unit& u, int wr, int wc, int fr, int fq) const {
        const int row0 = u.pm * BM + wr * 64 + fr;
        if (u.slice >= 0) {
            PG8_GAS float* sb = slab + ((size_t)u.slice * slab_rows + (row0 - row_base)) * (2 * ldc) + u.pn * BM + wc * 32 + 4 * fq;
#pragma unroll
            for (int ai = 0; ai < 2; ++ai)
#pragma unroll
                for (int m = 0; m < 4; ++m) { PG8_GAS float* rowp = sb + (size_t)(ai * HALF + m * 16) * (2 * ldc);
#pragma unroll
                    for (int bj = 0; bj < 2; ++bj)
#pragma unroll
                        for (int n = 0; n < 2; ++n) *(PG8_GAS f32x4*)(rowp + bj * HALF + n * 16) = acc[ai][bj][m][n]; }
            return;
        }
        const int col0 = u.pn * HALF + wc * 32 + 4 * fq;
        f32x4 b1[2], b2[2];
#pragma unroll
        for (int n = 0; n < 2; ++n) { b1[n] = *(const PG8_GAS f32x4*)(bias + col0 + n * 16); b2[n] = *(const PG8_GAS f32x4*)(bias + nhalf + col0 + n * 16); }
#pragma unroll
        for (int ai = 0; ai < 2; ++ai)
#pragma unroll
            for (int m = 0; m < 4; ++m) { PG8_GAS float* rowp = X + (size_t)(row0 + ai * HALF + m * 16) * ldc + col0;
#pragma unroll
                for (int n = 0; n < 2; ++n) { const f32x4 z1 = acc[ai][0][m][n] + b1[n], z2 = acc[ai][1][m][n] + b2[n]; f32x4 o = *(const PG8_GAS f32x4*)(rowp + n * 16);
#pragma unroll
                    for (int j = 0; j < 4; ++j) o[j] += z1[j] * fast_sigmoid(z2[j]);
                    *(PG8_GAS f32x4*)(rowp + n * 16) = o; }
                if (m == 3) asm volatile("" ::: "memory"); }
    }
};
template <class Epi, class Sched, bool ALIGN_EPI = false, bool SP2 = false>
__device__ __forceinline__ void gemm_phase(PG8_LAS unsigned char* lds, const Gemm g, const Sched& S, const Epi& E, int tid_in) {
    int tid_ = tid_in; asm volatile("" : "+v"(tid_));
    const int tid = tid_, wid = __builtin_amdgcn_readfirstlane(tid >> 6), lane = tid & 63, wr = wid >> 2, wc = wid & 3, fr = lane & 15, fq = lane >> 4;
    const int K = g.K;
    unsigned voffA[2], voffB[2];
#pragma unroll
    for (int i = 0; i < 2; ++i) { int R, C; stage_rc(tid * 16 + i * 8192, R, C); const int Rb = Epi::PERM ? ((R & ~31) + perm32(R & 31)) : R;
        voffA[i] = (unsigned)(R * K + C) * 2u; voffB[i] = (unsigned)(Rb * K + C) * 2u; }
    const size_t kstep = (size_t)(BK * 2);
    const size_t hstep = (size_t)HALF * K * 2;
    const size_t tstep = 2 * hstep;
    const unsigned ldsw = (unsigned)wid * 1024u;
    const int aoff = lds_byte(wr * 64 + fr, fq * 8), boff = lds_byte(wc * 32 + fr, fq * 8);
#define PG8_SA(b, h) (((b) * 2 + (h)) * HTB)
#define PG8_SB(b, h) ((4 + (b) * 2 + (h)) * HTB)
#define PG8_STAGE(bufoff, gbase, voff) do { _Pragma("unroll") for (int _i = 0; _i < 2; ++_i) \
        __builtin_amdgcn_global_load_lds((const PG8_GAS unsigned*)((const PG8_GAS char*)(gbase) + (voff)[_i]), (PG8_LAS unsigned*)(lds + (bufoff) + ldsw + _i * 8192), 16, 0, 0); } while (0)
#define PG8_LDA(dst, b, h) do { _Pragma("unroll") for (int m = 0; m < 4; ++m) _Pragma("unroll") for (int k = 0; k < 2; ++k) dst[m][k] = *(const PG8_LAS bf16x8*)(lds + PG8_SA(b, h) + aoff + m * 2048 + k * 1024); } while (0)
#define PG8_LDB(dst, b, h) do { _Pragma("unroll") for (int n = 0; n < 2; ++n) _Pragma("unroll") for (int k = 0; k < 2; ++k) dst[n][k] = *(const PG8_LAS bf16x8*)(lds + PG8_SB(b, h) + boff + n * 2048 + k * 1024); } while (0)
#define PG8_MMA(ai, bj, At, Bt) do { __builtin_amdgcn_s_setprio(1); _Pragma("unroll") for (int m = 0; m < 4; ++m) _Pragma("unroll") for (int n = 0; n < 2; ++n) _Pragma("unroll") for (int k = 0; k < 2; ++k) \
        acc[ai][bj][m][n] = __builtin_amdgcn_mfma_f32_16x16x32_bf16(Bt[n][k], At[m][k], acc[ai][bj][m][n], 0, 0, 0); __builtin_amdgcn_s_setprio(0); } while (0)
#define PG8_WAIT_V(n) asm volatile("s_waitcnt vmcnt(" #n ")" ::: "memory")
#define PG8_WAIT_L(n) asm volatile("s_waitcnt lgkmcnt(" #n ")" ::: "memory")
#define PG8_BAR __builtin_amdgcn_s_barrier()
#define PG8_SCHED __builtin_amdgcn_sched_barrier(0)
    Unit cur, nxt; int ui = 0;
    if (!S.next(0, cur)) return;
    f32x4 acc[2][2][4][2];
#pragma unroll
    for (int a = 0; a < 2; ++a)
#pragma unroll
        for (int b = 0; b < 2; ++b)
#pragma unroll
            for (int m = 0; m < 4; ++m)
#pragma unroll
                for (int n = 0; n < 2; ++n) acc[a][b][m][n] = (f32x4){0.f, 0.f, 0.f, 0.f};
    bf16x8 At[4][2], B0[2][2], B1[2][2];
    const PG8_GAS char* cA = (const PG8_GAS char*)g.A + (size_t)cur.pm * tstep + (size_t)cur.k0 * 2; const PG8_GAS char* cB = (const PG8_GAS char*)g.Bt + (size_t)cur.pn * tstep + (size_t)cur.k0 * 2;
    S.a_ready(cur);
    if constexpr (SP2) {
        PG8_STAGE(PG8_SB(0, 0), cB, voffB); PG8_STAGE(PG8_SB(0, 1), cB + hstep, voffB); PG8_STAGE(PG8_SA(0, 0), cA, voffA); PG8_STAGE(PG8_SA(0, 1), cA + hstep, voffA);
        if (wr == 1) PG8_BAR;
        PG8_WAIT_V(2); PG8_BAR;
        PG8_STAGE(PG8_SB(1, 0), cB + kstep, voffB); PG8_STAGE(PG8_SA(1, 0), cA + kstep, voffA); PG8_STAGE(PG8_SB(1, 1), cB + hstep + kstep, voffB);
        PG8_WAIT_V(6); PG8_BAR;
    } else {
        PG8_STAGE(PG8_SB(0, 0), cB, voffB); PG8_STAGE(PG8_SA(0, 0), cA, voffA); PG8_STAGE(PG8_SB(0, 1), cB + hstep, voffB); PG8_STAGE(PG8_SA(0, 1), cA + hstep, voffA);
        if (wr == 1) PG8_BAR;
        PG8_WAIT_V(4); PG8_BAR;
        PG8_STAGE(PG8_SB(1, 0), cB + kstep, voffB); PG8_STAGE(PG8_SA(1, 0), cA + kstep, voffA); PG8_STAGE(PG8_SB(1, 1), cB + hstep + kstep, voffB);
        PG8_WAIT_V(6); PG8_BAR;
    }
    for (;;) {
        const bool has_next = S.next(ui + 1, nxt);
        const PG8_GAS char* nA = has_next ? (const PG8_GAS char*)g.A + (size_t)nxt.pm * tstep + (size_t)nxt.k0 * 2 : cA; const PG8_GAS char* nB = has_next ? (const PG8_GAS char*)g.Bt + (size_t)nxt.pn * tstep + (size_t)nxt.k0 * 2 : cB;
        const int nt = cur.nt;
        for (int t = 0; t < nt; t += 2) {
            const bool last = (t == nt - 2);
            const PG8_GAS char* a1 = cA + (size_t)(t + 1) * kstep;
            const PG8_GAS char* a2 = last ? nA : cA + (size_t)(t + 2) * kstep; const PG8_GAS char* b2 = last ? nB : cB + (size_t)(t + 2) * kstep;
            const PG8_GAS char* a3 = a2 + kstep; const PG8_GAS char* b3 = b2 + kstep;
            if (last && has_next) S.a_ready(nxt);
            if constexpr (SP2) {
            PG8_LDB(B0, 0, 0); PG8_LDB(B1, 0, 1); PG8_SCHED; PG8_LDA(At, 0, 0); PG8_STAGE(PG8_SA(1, 1), a1 + hstep, voffA);
            PG8_WAIT_V(8); PG8_WAIT_L(0); PG8_BAR; PG8_MMA(0, 0, At, B0); PG8_MMA(0, 1, At, B1); PG8_BAR; PG8_SCHED;
            PG8_LDA(At, 0, 1); PG8_STAGE(PG8_SB(0, 0), b2, voffB); PG8_STAGE(PG8_SB(0, 1), b2 + hstep, voffB); PG8_STAGE(PG8_SA(0, 0), a2, voffA);
            PG8_WAIT_V(8); PG8_WAIT_L(0); PG8_BAR; PG8_MMA(1, 0, At, B0); PG8_MMA(1, 1, At, B1); PG8_BAR; PG8_SCHED;
            PG8_LDB(B0, 1, 0); PG8_LDB(B1, 1, 1); PG8_SCHED; PG8_LDA(At, 1, 0); PG8_STAGE(PG8_SA(0, 1), a2 + hstep, voffA);
            PG8_WAIT_V(8); PG8_WAIT_L(0); PG8_BAR; PG8_MMA(0, 0, At, B0); PG8_MMA(0, 1, At, B1); PG8_BAR; PG8_SCHED;
            PG8_LDA(At, 1, 1); PG8_STAGE(PG8_SB(1, 0), b3, voffB); PG8_STAGE(PG8_SB(1, 1), b3 + hstep, voffB); PG8_STAGE(PG8_SA(1, 0), a3, voffA);
            PG8_WAIT_V(8); PG8_WAIT_L(0); PG8_BAR; PG8_MMA(1, 0, At, B0); PG8_MMA(1, 1, At, B1); PG8_BAR; PG8_SCHED;
            } else {
            PG8_LDB(B0, 0, 0); PG8_SCHED; PG8_LDA(At, 0, 0); PG8_STAGE(PG8_SA(1, 1), a1 + hstep, voffA);
            PG8_WAIT_L(8); PG8_BAR; PG8_WAIT_L(0); PG8_MMA(0, 0, At, B0); PG8_BAR; PG8_SCHED;
            PG8_LDB(B1, 0, 1); PG8_STAGE(PG8_SB(0, 0), b2, voffB);
            PG8_BAR; PG8_WAIT_L(0); PG8_MMA(0, 1, At, B1); PG8_BAR;
            PG8_LDA(At, 0, 1); PG8_STAGE(PG8_SA(0, 0), a2, voffA);
            PG8_BAR; PG8_WAIT_L(0); PG8_MMA(1, 0, At, B0); PG8_BAR; PG8_SCHED;
            PG8_STAGE(PG8_SB(0, 1), b2 + hstep, voffB);
            PG8_WAIT_V(6); PG8_BAR; PG8_MMA(1, 1, At, B1); PG8_BAR;
            PG8_LDB(B0, 1, 0); PG8_SCHED; PG8_LDA(At, 1, 0); PG8_STAGE(PG8_SA(0, 1), a2 + hstep, voffA);
            PG8_WAIT_L(8); PG8_BAR; PG8_WAIT_L(0); PG8_MMA(0, 0, At, B0); PG8_BAR; PG8_SCHED;
            PG8_LDB(B1, 1, 1); PG8_STAGE(PG8_SB(1, 0), b3, voffB);
            PG8_BAR; PG8_WAIT_L(0); PG8_MMA(0, 1, At, B1); PG8_BAR;
            PG8_LDA(At, 1, 1); PG8_STAGE(PG8_SA(1, 0), a3, voffA);
            PG8_BAR; PG8_WAIT_L(0); PG8_MMA(1, 0, At, B0); PG8_BAR; PG8_SCHED;
            PG8_STAGE(PG8_SB(1, 1), b3 + hstep, voffB);
            PG8_WAIT_V(6); PG8_BAR; PG8_MMA(1, 1, At, B1); PG8_BAR;
            }
        }
        if constexpr (ALIGN_EPI) { if (wr == 0) PG8_BAR; }
        if constexpr (!Epi::AFTER_DRAIN) { E(acc, cur, wr, wc, fr, fq); S.done(cur); }
        if (!has_next) break;
#pragma unroll
        for (int a = 0; a < 2; ++a)
#pragma unroll
            for (int b = 0; b < 2; ++b)
#pragma unroll
                for (int m = 0; m < 4; ++m)
#pragma unroll
                    for (int n = 0; n < 2; ++n) acc[a][b][m][n] = (f32x4){0.f, 0.f, 0.f, 0.f};
        cur = nxt; cA = nA; cB = nB; ++ui;
        if constexpr (ALIGN_EPI) { if (wr == 1) PG8_BAR; }
    }
    PG8_WAIT_V(0);
    if constexpr (!ALIGN_EPI) { if (wr == 0) PG8_BAR; }
    PG8_BAR;
    if constexpr (Epi::AFTER_DRAIN) { E.fused(acc, cur, wr, wc, fr, fq, lds, wid, lane); S.done(cur); }
#undef PG8_SA
#undef PG8_SB
#undef PG8_STAGE
#undef PG8_LDA
#undef PG8_LDB
#undef PG8_MMA
#undef PG8_WAIT_V
#undef PG8_WAIT_L
#undef PG8_BAR
#undef PG8_SCHED
}
}
constexpr int NWAVES = 8, NTHR = 512;
constexpr int D = 2048, BATCH = 4, SEQ = 2048, DEC_B = 128, DEC_T = 4, PAST = 16384;
constexpr int MP = BATCH * SEQ;
constexpr int MS = DEC_B * DEC_T;
constexpr int M = MP + MS;
constexpr int HALFW = 1024, RH = 4, DK = 256, LRU_W = 1024, LRU_H = 8, LRU_BLK = 128, INW = 6144;
constexpr int SG = 128, SP = 64, FF = 5632, NCH = 16, CH = 128;
constexpr float EPS = 1e-6f;
constexpr int NPOS = SEQ + DEC_T;

enum { I_XP = 0, I_XS, I_SRET, I_SLRU, I_SCONV, I_SSRE, I_SSIM, I_NME, I_WIN, I_CW, I_CB, I_WA, I_BA, I_WX, I_BX, I_LAM, I_WOUT, I_NMO, I_ARE, I_AIM,
       I_BRE, I_BIM, I_CRE, I_CIM, I_SD, I_LDT, I_WGLU, I_BGLU, I_NF, I_WGU, I_WDN, I_NFIN, N_IN };

constexpr size_t O_YP = 0, O_YS = O_YP + (size_t)MP * D, O_RETP = O_YS + (size_t)MS * D, O_RETS = O_RETP + (size_t)2 * BATCH * RH * DK * DK,
                 O_LRUP = O_RETS + (size_t)2 * DEC_B * RH * DK * DK, O_LRUS = O_LRUP + (size_t)2 * BATCH * LRU_W, O_CONVP = O_LRUS + (size_t)2 * DEC_B * LRU_W,
                 O_CONVS = O_CONVP + (size_t)2 * BATCH * 3 * LRU_W, O_SREP = O_CONVS + (size_t)2 * DEC_B * 3 * LRU_W, O_SRES = O_SREP + (size_t)2 * BATCH * SG * SP,
                 O_SIMP = O_SRES + (size_t)2 * DEC_B * SG * SP, O_SIMS = O_SIMP + (size_t)2 * BATCH * SG * SP, O_END = O_SIMS + (size_t)2 * DEC_B * SG * SP;

constexpr size_t al256(size_t x) { return (x + 255) & ~(size_t)255; }
constexpr size_t WS_CTL = 0, CTL_BYTES = 1u << 20, CTL_ZERO_BYTES = 32768;
constexpr size_t SZ_WIN = (size_t)INW * D * 2, SZ_WOUT = (size_t)D * D * 2, SZ_WGLU = (size_t)2 * D * D * 2, SZ_WGU = (size_t)2 * FF * D * 2, SZ_WDN = (size_t)D * FF * 2;
constexpr size_t WS_WIN = CTL_BYTES, WS_WOUT = WS_WIN + 2 * SZ_WIN, WS_WGLU = WS_WOUT + 2 * SZ_WOUT, WS_WGU = WS_WGLU + 2 * SZ_WGLU, WS_WDN = WS_WGU + 4 * SZ_WGU;
constexpr size_t WS_X = WS_WDN + 4 * SZ_WDN;
constexpr size_t WS_XN = WS_X + (size_t)M * D * 4;
constexpr size_t WS_PROJ = WS_XN + (size_t)M * D * 2;
constexpr size_t WS_H = WS_PROJ + (size_t)M * INW * 2;
constexpr size_t WS_CAT = WS_H + (size_t)M * FF * 2;
constexpr size_t WS_UT = WS_CAT + (size_t)M * D * 2;
constexpr size_t WS_ROPE = WS_UT + (size_t)256 * 65536 * 4;
constexpr size_t WS_LRUW = al256(WS_ROPE + (size_t)2 * NPOS * 128 * 4);
constexpr size_t WS_LRUC = WS_LRUW + (size_t)2 * 8 * 256 * 128 * 2;
constexpr size_t WS_LSA = WS_LRUC + (size_t)2 * 1024 * 4;
constexpr size_t WS_LSB = WS_LSA + (size_t)4 * 16 * 1024 * 4;
constexpr size_t WS_LCIN = WS_LSB + (size_t)4 * 16 * 1024 * 4;
constexpr size_t WS_S5BB = WS_LCIN + (size_t)4 * 16 * 1024 * 4;
constexpr size_t WS_S5CM = WS_S5BB + (size_t)2 * 128 * 128 * 16 * 2;
constexpr size_t WS_S5AB = WS_S5CM + (size_t)2 * 128 * 16 * 128 * 2;
constexpr size_t WS_S5LOC = WS_S5AB + (size_t)2 * 8192 * 4 * 4;
constexpr size_t WS_SLAB = WS_S5LOC + (size_t)4 * 16 * 8192 * 2 * 4;
constexpr size_t WS_S5PW = WS_SLAB + (size_t)8 * 512 * 4096 * 4;
constexpr size_t WS_END = WS_S5PW + (size_t)2 * 128 * 8 * 8 * 64 * 8;
constexpr int S_DN = 11, S_OUT = 8, S_GLU = 4;
static_assert(WS_END < (size_t)1000 * 1000 * 1000, "workspace map must stay below the guaranteed d_ws size");
constexpr int CW_BAR = 4096;
static_assert((CW_BAR + 3456) * 4 <= (int)CTL_ZERO_BYTES, "barrier words inside the zeroed region");

constexpr int LDS_BYTES = 147456;
constexpr int MISC_OFF = 146944;
constexpr int PH_LDS = 146944;

constexpr int NPHASE = 1 + 9 * 4;
#ifndef MK_ONE_LAUNCH
#define MK_ONE_LAUNCH 0
#endif
#define GAS __attribute__((address_space(1)))
#define LAS __attribute__((address_space(3)))
typedef unsigned short __attribute__((may_alias)) bf16;
typedef unsigned v4u __attribute__((ext_vector_type(4), may_alias));
typedef unsigned v2u __attribute__((ext_vector_type(2), may_alias));
typedef float f32x4 __attribute__((ext_vector_type(4), may_alias));
typedef float f32x2 __attribute__((ext_vector_type(2), may_alias));
typedef short bf16x8 __attribute__((ext_vector_type(8), may_alias));
typedef short bf16x4 __attribute__((ext_vector_type(4), may_alias));
typedef unsigned __attribute__((may_alias)) u32a;
typedef float __attribute__((may_alias)) f32a;
#define LDS_WAIT() asm volatile("s_waitcnt lgkmcnt(0)" ::: "memory")
#define VM_WAIT() asm volatile("s_waitcnt vmcnt(0)" ::: "memory")
typedef __bf16 bf16v2 __attribute__((ext_vector_type(2)));
typedef float f32v2c __attribute__((ext_vector_type(2)));
__device__ __forceinline__ unsigned pk2(float lo, float hi) { const f32v2c v = {lo, hi}; return __builtin_bit_cast(unsigned, __builtin_convertvector(v, bf16v2)); }
__device__ __forceinline__ unsigned f2bf(float f) { return pk2(f, f) & 0xffffu; }
__device__ __forceinline__ float bflo(unsigned w) { return __builtin_bit_cast(float, w << 16); }
__device__ __forceinline__ float bfhi(unsigned w) { return __builtin_bit_cast(float, w & 0xffff0000u); }
__device__ __forceinline__ float bf2f(bf16 h) { return __builtin_bit_cast(float, (unsigned)h << 16); }
__device__ __forceinline__ float wave_sum(float v) {
#pragma unroll
    for (int o = 1; o < 64; o <<= 1) v += __shfl_xor(v, o);
    return v;
}
__device__ __forceinline__ float sigmoidf_(float x) { return __builtin_amdgcn_rcpf(1.0f + __builtin_amdgcn_exp2f(-1.44269504f * x)); }
__device__ __forceinline__ float siluf_(float x) { return x * sigmoidf_(x); }
__device__ __forceinline__ float geluf_(float x) { const float u = 0.7978845608f * (x + 0.044715f * x * x * x); return x * sigmoidf_(2.0f * u); }
#define MFMA32(a, b, c) __builtin_amdgcn_mfma_f32_16x16x32_bf16((a), (b), (c), 0, 0, 0)
#define MFMA16(a, b, c) __builtin_amdgcn_mfma_f32_16x16x16bf16_1k((a), (b), (c), 0, 0, 0)
#if defined(__HIP_DEVICE_COMPILE__)
#define ASSUME_GLOBAL(p) __builtin_assume(!__builtin_amdgcn_is_shared((const __attribute__((address_space(0))) void*)(p)) && !__builtin_amdgcn_is_private((const __attribute__((address_space(0))) void*)(p)))
#else
#define ASSUME_GLOBAL(p) ((void)0)
#endif
#define XB_TMO      128
#define XB_XCNT(j)  (256  + 64 * (j))
#define XB_XSUB(j)  (1280 + 64 * (j))
#define XB_XGEN(j)  (2304 + 64 * (j))
#define XB_TOP      3328
#define XB_TOPGEN   3392
#define XCD_BAR_WORDS 3456
#define XB_SPIN_CAP (1u << 18)

__device__ __forceinline__ unsigned xb_ld(unsigned* p)              { return __hip_atomic_load(p, __ATOMIC_RELAXED, __HIP_MEMORY_SCOPE_AGENT); }
__device__ __forceinline__ unsigned xb_add(unsigned* p, unsigned v) { return __hip_atomic_fetch_add(p, v, __ATOMIC_RELAXED, __HIP_MEMORY_SCOPE_AGENT); }
__device__ __forceinline__ unsigned xb_xcc_id() { return (unsigned)__builtin_amdgcn_s_getreg((3 << 11) | 20) & 0xFu; }
#define XB_SPIN(cond, bar) do { unsigned _sp = 0; while (cond) { __builtin_amdgcn_s_sleep(1); \
    if ((++_sp & 255u) == 0u) { if (xb_ld(&(bar)[XB_TMO])) break; if (_sp > XB_SPIN_CAP) { atomicAdd(&(bar)[XB_TMO], 1u); break; } } } } while (0)

struct XcdBarrier {
    unsigned* bar; unsigned x;
    volatile LAS unsigned* st;
};

__device__ __forceinline__ XcdBarrier xcd_barrier_post(unsigned* bar, volatile LAS unsigned* st) {
    XcdBarrier b; b.bar = bar; b.x = xb_xcc_id(); b.st = st;
    if (threadIdx.x == 0) (void)xb_add(&bar[XB_XCNT(b.x)], 1u);
    return b;
}
__device__ __forceinline__ void xcd_barrier_complete(unsigned* bar, unsigned x, unsigned& nloc, unsigned& nx) {
    const unsigned G = gridDim.x * gridDim.y * gridDim.z;
    unsigned sum, cnt, mine, sp = 0u;
    for (;;) {
        sum = 0u; cnt = 0u; mine = 0u;
#pragma unroll
        for (unsigned j = 0; j < 16; ++j) { const unsigned c = xb_ld(&bar[XB_XCNT(j)]); sum += c; cnt += (c > 0u) ? 1u : 0u; mine = (j == x) ? c : mine; }
        if (sum == G) break;
        __builtin_amdgcn_s_sleep(1);
        if ((++sp & 255u) == 0u) { if (xb_ld(&bar[XB_TMO])) break; if (sp > XB_SPIN_CAP) { atomicAdd(&bar[XB_TMO], 1u); break; } }
    }
    nloc = mine > 0u ? mine : 1u; nx = cnt > 0u ? cnt : 1u;
}

__device__ __forceinline__ void xcd_barrier(const XcdBarrier& b, int tid_) {
    asm volatile("s_waitcnt vmcnt(0)" ::: "memory");
    __syncthreads();
    if (tid_ == 0) {
        unsigned* bar = b.bar;
        __builtin_amdgcn_s_waitcnt(0);
        unsigned nloc = b.st[0], nx = b.st[1];
        if (nloc == 0u) { xcd_barrier_complete(bar, b.x, nloc, nx); b.st[0] = nloc; b.st[1] = nx; }
        const unsigned old = xb_add(&bar[XB_XSUB(b.x)], 1u);
        const unsigned gen = old / nloc;
        if (old + 1u == (gen + 1u) * nloc) {
            __builtin_amdgcn_fence(__ATOMIC_RELEASE, "agent");
            asm volatile("s_waitcnt vmcnt(0)" ::: "memory");
            const unsigned og = xb_add(&bar[XB_TOP], 1u);
            const unsigned tg = og / nx;
            if (og + 1u == (tg + 1u) * nx) xb_add(&bar[XB_TOPGEN], 1u);
            else XB_SPIN(xb_ld(&bar[XB_TOPGEN]) == tg, bar);
            __builtin_amdgcn_fence(__ATOMIC_ACQUIRE, "agent");
            xb_add(&bar[XB_XGEN(b.x)], 1u);
            asm volatile("s_waitcnt vmcnt(0)" ::: "memory");
        } else {
            XB_SPIN(xb_ld(&bar[XB_XGEN(b.x)]) == gen, bar);
            __builtin_amdgcn_fence(__ATOMIC_ACQUIRE, "agent");
            asm volatile("s_waitcnt vmcnt(0)" ::: "memory");
        }
    }
    __syncthreads();
}
struct Frame {
    LAS unsigned char* lds;
    int tid, lane, wave, G, bid;
    GAS float* out; GAS unsigned char* ws;
    __device__ __forceinline__ const GAS float* inp(int i) const {
        const __attribute__((address_space(4))) char* ka = (const __attribute__((address_space(4))) char*)__builtin_amdgcn_kernarg_segment_ptr();
        return (const GAS float*)*(volatile const __attribute__((address_space(4))) unsigned long long*)(ka + 8 * i);
    }
};

__device__ __forceinline__ void tr_item(const GAS float* W, int K, int N, GAS bf16* WT, int k0, int n0, int dst_row0, const GAS float* gain, LAS float* scr, int lane) {
    const int kr = lane >> 3, c4 = lane & 7;
    f32x4 v[8];
#pragma unroll
    for (int i = 0; i < 8; ++i) v[i] = __builtin_nontemporal_load((const GAS f32x4*)(W + (size_t)(k0 + 8 * i + kr) * N + n0 + 4 * c4));
    if (gain) {
#pragma unroll
        for (int i = 0; i < 8; ++i) v[i] = v[i] * gain[k0 + 8 * i + kr]; }
#pragma unroll
    for (int i = 0; i < 8; ++i) { LAS float* d = scr + (8 * i + kr) * 33 + 4 * c4; d[0] = v[i].x; d[1] = v[i].y; d[2] = v[i].z; d[3] = v[i].w; }
    LDS_WAIT(); asm volatile("" ::: "memory");
    const int c = lane & 7;
#pragma unroll
    for (int j = 0; j < 4; ++j) { const int n = (lane >> 3) + 8 * j; const LAS float* s = scr + (8 * c) * 33 + n;
        v4u o; o.x = pk2(s[0 * 33], s[1 * 33]); o.y = pk2(s[2 * 33], s[3 * 33]); o.z = pk2(s[4 * 33], s[5 * 33]); o.w = pk2(s[6 * 33], s[7 * 33]);
        *(GAS v4u*)(WT + (size_t)(dst_row0 + n) * K + k0 + 8 * c) = o; }
    LDS_WAIT(); asm volatile("" ::: "memory");
}
__device__ __forceinline__ int pair_row(int n, int Fh) { const int half = n / Fh, j = n - half * Fh; return (j >> 7) * 256 + half * 128 + (j & 127); }
__device__ __forceinline__ void sincos_pi(double r, double& s, double& c) {
    const double x2 = r * r; double ts = 1.0, tc = 1.0, ss = 1.0, cc = 1.0;
#pragma unroll
    for (int k = 1; k <= 14; ++k) { tc *= -x2 / (double)((2 * k - 1) * (2 * k)); cc += tc; ts *= -x2 / (double)((2 * k) * (2 * k + 1)); ss += ts; }
    s = r * ss; c = cc;
}
__device__ __forceinline__ void sincos_big(double ang, double& s, double& c) {
    const double TWO_PI = 6.283185307179586476925286766559; const double k = rint(ang / TWO_PI); sincos_pi(ang - k * TWO_PI, s, c);
}
template <int FIN>
__device__ __forceinline__ void rms_row(const GAS float* xrow, GAS float* xcopy, GAS bf16* orow, GAS float* frow, const GAS float* gain, int lane, const GAS float* slab0, size_t spitch, int ns, const GAS float* gbias) {
    const GAS f32x4* xr = (const GAS f32x4*)xrow + lane;
    f32x4 v[8]; float s = 0.f;
#pragma unroll
    for (int j = 0; j < 8; ++j) v[j] = xr[64 * j];
    if (FIN == 1) {
#pragma unroll 1
        for (int sl = 0; sl < ns; ++sl) { const GAS f32x4* pr = (const GAS f32x4*)(slab0 + (size_t)sl * spitch) + lane;
#pragma unroll
            for (int j = 0; j < 8; ++j) v[j] += pr[64 * j]; } }
    if (FIN == 2) {
        f32x4 z1[8], z2[8];
#pragma unroll
        for (int j = 0; j < 8; ++j) { const int c = 4 * lane + 256 * j; z1[j] = *(const GAS f32x4*)(gbias + c); z2[j] = *(const GAS f32x4*)(gbias + D + c); }
#pragma unroll 1
        for (int sl = 0; sl < ns; ++sl) { const GAS float* pr = slab0 + (size_t)sl * spitch;
#pragma unroll
            for (int j = 0; j < 8; ++j) { const int c = 4 * lane + 256 * j, gc = (c >> 7) * 256 + (c & 127); z1[j] += *(const GAS f32x4*)(pr + gc); z2[j] += *(const GAS f32x4*)(pr + gc + 128); } }
#pragma unroll
        for (int j = 0; j < 8; ++j) { v[j].x += z1[j].x * sigmoidf_(z2[j].x); v[j].y += z1[j].y * sigmoidf_(z2[j].y); v[j].z += z1[j].z * sigmoidf_(z2[j].z); v[j].w += z1[j].w * sigmoidf_(z2[j].w); } }
#pragma unroll
    for (int j = 0; j < 8; ++j) s += (v[j].x * v[j].x + v[j].y * v[j].y) + (v[j].z * v[j].z + v[j].w * v[j].w);
    const float rstd = 1.0f / sqrtf(wave_sum(s) * (1.f / D) + EPS);
    if (xcopy) { GAS f32x4* xc = (GAS f32x4*)xcopy + lane;
#pragma unroll
        for (int j = 0; j < 8; ++j) xc[64 * j] = v[j]; }
#pragma unroll
    for (int j = 0; j < 8; ++j) { f32x4 g = (f32x4){1.f, 1.f, 1.f, 1.f}; if (gain) g = ((const GAS f32x4*)gain)[lane + 64 * j]; v[j] = v[j] * rstd * g; }
    if (orow) { GAS v2u* o8 = (GAS v2u*)orow + lane;
#pragma unroll
        for (int j = 0; j < 8; ++j) { v2u w; w.x = pk2(v[j].x, v[j].y); w.y = pk2(v[j].z, v[j].w); o8[64 * j] = w; } }
    else { GAS f32x4* o = (GAS f32x4*)frow + lane;
#pragma unroll
        for (int j = 0; j < 8; ++j) o[64 * j] = v[j]; }
}
__device__ __forceinline__ void rms_phase(const Frame& F, int mode, const GAS float* gain, int fin, int ns, const GAS float* gbias) {
    const int gw = F.bid * NWAVES + F.wave, NGW = F.G * NWAVES;
    GAS float* X = (GAS float*)(F.ws + WS_X); GAS bf16* XN = (GAS bf16*)(F.ws + WS_XN); const GAS float* SLAB = (const GAS float*)(F.ws + WS_SLAB);
    {
        LAS float* red = (LAS float*)F.lds;
        const int sub = F.wave & 3, rsel = F.wave >> 2;
#pragma unroll 1
        for (int r0 = 2 * F.bid; r0 < MS; r0 += 2 * F.G) {
            const int m = MP + r0 + rsel; GAS float* xr = X + (size_t)m * D + 512 * sub;
            f32x4 v[2]; v[0] = ((const GAS f32x4*)xr)[F.lane]; v[1] = ((const GAS f32x4*)xr)[F.lane + 64];
            if (fin == 1) { const GAS float* sl = SLAB + (size_t)(r0 + rsel) * D + 512 * sub;
                for (int s = 0; s < ns; ++s) { v[0] += ((const GAS f32x4*)(sl + (size_t)s * MS * D))[F.lane]; v[1] += ((const GAS f32x4*)(sl + (size_t)s * MS * D))[F.lane + 64]; } }
            else { f32x4 z1[2], z2[2];
#pragma unroll
                for (int j = 0; j < 2; ++j) { const int c = 512 * sub + 4 * F.lane + 256 * j; z1[j] = *(const GAS f32x4*)(gbias + c); z2[j] = *(const GAS f32x4*)(gbias + D + c); }
                const GAS float* sl = SLAB + (size_t)(r0 + rsel) * 2 * D;
                for (int s = 0; s < ns; ++s) {
#pragma unroll
                    for (int j = 0; j < 2; ++j) { const int c = 512 * sub + 4 * F.lane + 256 * j, gc = (c >> 7) * 256 + (c & 127); z1[j] += *(const GAS f32x4*)(sl + (size_t)s * MS * 2 * D + gc); z2[j] += *(const GAS f32x4*)(sl + (size_t)s * MS * 2 * D + gc + 128); } }
#pragma unroll
                for (int j = 0; j < 2; ++j) { v[j].x += z1[j].x * sigmoidf_(z2[j].x); v[j].y += z1[j].y * sigmoidf_(z2[j].y); v[j].z += z1[j].z * sigmoidf_(z2[j].z); v[j].w += z1[j].w * sigmoidf_(z2[j].w); } }
            float ss = 0.f;
#pragma unroll
            for (int j = 0; j < 2; ++j) ss += (v[j].x * v[j].x + v[j].y * v[j].y) + (v[j].z * v[j].z + v[j].w * v[j].w);
            ss = wave_sum(ss);
            __syncthreads(); if (F.lane == 0) red[F.wave] = ss; __syncthreads();
            const float rstd = 1.0f / sqrtf(((red[4 * rsel] + red[4 * rsel + 1]) + (red[4 * rsel + 2] + red[4 * rsel + 3])) * (1.f / D) + EPS);
            ((GAS f32x4*)xr)[F.lane] = v[0]; ((GAS f32x4*)xr)[F.lane + 64] = v[1];
#pragma unroll
            for (int j = 0; j < 2; ++j) { f32x4 g = (f32x4){1.f, 1.f, 1.f, 1.f}; if (mode != 0) g = *(const GAS f32x4*)(gain + 512 * sub + 4 * (F.lane + 64 * j)); const f32x4 o = v[j] * rstd * g;
                if (mode == 2) *(GAS f32x4*)(F.out + O_YP + (size_t)m * D + 512 * sub + 4 * (F.lane + 64 * j)) = o;
                else { v2u w; w.x = pk2(o.x, o.y); w.y = pk2(o.z, o.w); *(GAS v2u*)(XN + (size_t)m * D + 512 * sub + 4 * (F.lane + 64 * j)) = w; } }
        }
    }
#ifndef REP_RMSP
#define REP_RMSP 0
#endif
    for (int rep = 0; rep <= REP_RMSP; ++rep)
    for (int m = gw; m < MP; m += NGW) {
        if (mode == 2) rms_row<0>(X + (size_t)m * D, nullptr, nullptr, F.out + O_YP + (size_t)m * D, gain, F.lane, nullptr, 0, 0, nullptr);
        else rms_row<0>(X + (size_t)m * D, nullptr, XN + (size_t)m * D, nullptr, mode == 1 ? gain : nullptr, F.lane, nullptr, 0, 0, nullptr);
    }
}

constexpr int IT_IN = 32 * (INW / 32), IT_OUT = 32 * (D / 32), IT_GLU = 32 * (2 * D / 32), IT_GU = 32 * (2 * FF / 32), IT_DN = (FF / 64) * (D / 32);
constexpr int CV_E0 = IT_IN, CV_E1 = CV_E0 + IT_OUT, CV_E2 = CV_E1 + IT_GU, CV_E3 = CV_E2 + IT_DN, CV_E4 = CV_E3 + IT_GLU, CV_E5 = CV_E4 + IT_GU, CV_E6 = CV_E5 + IT_DN,
              CV_E7 = CV_E6 + IT_IN, CV_E8 = CV_E7 + IT_OUT, CV_E9 = CV_E8 + IT_GU, CV_E10 = CV_E9 + IT_DN, CV_E11 = CV_E10 + IT_GLU, CV_E12 = CV_E11 + IT_GU, CV_E13 = CV_E12 + IT_DN;
constexpr int CV_T2E = CV_E3 + 2048, CV_T3E = CV_T2E + 4480, CV_T4E = CV_T3E + 2560;
constexpr int CV_T5E = CV_E6 + 4480;
constexpr int CV_T7E = CV_E10 + 2048, CV_T8E = CV_T7E + 4480, CV_T9E = CV_T8E + 2560;
static_assert(CV_T4E <= CV_E5 && CV_T9E <= CV_E12, "tail ranges stay inside the matrices needed later");
__device__ __forceinline__ void conv_item(const Frame& F, int it, LAS float* scr) {
    int r = it, seg_type, lay;
    if (r < CV_E0) { seg_type = 0; lay = 0; }
    else if (r < CV_E1) { r -= CV_E0; seg_type = 1; lay = 0; }
    else if (r < CV_E2) { r -= CV_E1; seg_type = 3; lay = 0; }
    else if (r < CV_E3) { r -= CV_E2; seg_type = 4; lay = 0; }
    else if (r < CV_E4) { r -= CV_E3; seg_type = 2; lay = 0; }
    else if (r < CV_E5) { r -= CV_E4; seg_type = 3; lay = 1; }
    else if (r < CV_E6) { r -= CV_E5; seg_type = 4; lay = 1; }
    else if (r < CV_E7) { r -= CV_E6; seg_type = 0; lay = 1; }
    else if (r < CV_E8) { r -= CV_E7; seg_type = 1; lay = 1; }
    else if (r < CV_E9) { r -= CV_E8; seg_type = 3; lay = 2; }
    else if (r < CV_E10) { r -= CV_E9; seg_type = 4; lay = 2; }
    else if (r < CV_E11) { r -= CV_E10; seg_type = 2; lay = 1; }
    else if (r < CV_E12) { r -= CV_E11; seg_type = 3; lay = 3; }
    else { r -= CV_E12; seg_type = 4; lay = 3; }
    const GAS float* W; GAS bf16* WT; const GAS float* gain = nullptr; int K = D, N, dst; int nblk;
    if (seg_type == 0) { N = INW; W = F.inp(I_WIN) + (size_t)lay * D * INW; WT = (GAS bf16*)(F.ws + WS_WIN + lay * SZ_WIN); gain = F.inp(I_NME) + lay * D; }
    else if (seg_type == 1) { N = D; W = F.inp(I_WOUT) + (size_t)lay * D * D; WT = (GAS bf16*)(F.ws + WS_WOUT + lay * SZ_WOUT); }
    else if (seg_type == 2) { N = 2 * D; W = F.inp(I_WGLU) + (size_t)lay * D * 2 * D; WT = (GAS bf16*)(F.ws + WS_WGLU + lay * SZ_WGLU); }
    else if (seg_type == 3) { N = 2 * FF; W = F.inp(I_WGU) + (size_t)lay * D * 2 * FF; WT = (GAS bf16*)(F.ws + WS_WGU + lay * SZ_WGU); gain = F.inp(I_NF) + lay * D; }
    else { N = D; K = FF; W = F.inp(I_WDN) + (size_t)lay * FF * D; WT = (GAS bf16*)(F.ws + WS_WDN + lay * SZ_WDN); }
    nblk = N / 32; const int kb = r / nblk, nb = r - kb * nblk;
    dst = seg_type == 2 ? pair_row(32 * nb, D) : (seg_type == 3 ? pair_row(32 * nb, FF) : 32 * nb);
    tr_item(W, K, N, WT, 64 * kb, 32 * nb, dst, gain, scr, F.lane);
}
__device__ __forceinline__ void conv_in_tail(const Frame& F, int lo, int hi, int nbusy) {
    if (F.bid < nbusy) return;
    LAS float* scr = (LAS float*)(F.lds + F.wave * 16384);
    const int w = (F.bid - nbusy) * NWAVES + F.wave, nw = (F.G - nbusy) * NWAVES;
    for (int it = lo + w; it < hi; it += nw) conv_item(F, it, scr);
}

__device__ __forceinline__ void p0_prologue(const Frame& F) {
    const int gw = F.bid * NWAVES + F.wave, NGW = F.G * NWAVES;
    { LAS float* scr = (LAS float*)(F.lds + F.wave * 16384);
      constexpr int N1 = CV_E0, N2 = CV_E6 - CV_T4E, N3 = CV_E13 - CV_T9E;
      for (int i = gw; i < N1 + N2 + N3; i += NGW) { const int it = i < N1 ? i : (i < N1 + N2 ? CV_T4E + (i - N1) : CV_T9E + (i - N1 - N2)); conv_item(F, it, scr); } }
    { GAS float* X = (GAS float*)(F.ws + WS_X); GAS bf16* XN = (GAS bf16*)(F.ws + WS_XN);
      for (int m = gw; m < M; m += NGW) { const GAS float* src = m < MP ? F.inp(I_XP) + (size_t)m * D : F.inp(I_XS) + (size_t)(m - MP) * D;
          rms_row<0>(src, X + (size_t)m * D, XN + (size_t)m * D, nullptr, nullptr, F.lane, nullptr, 0, 0, nullptr); } }
    const int gt = F.bid * NTHR + F.tid, NGT = F.G * NTHR;
    { GAS float* COS = (GAS float*)(F.ws + WS_ROPE); GAS float* SIN = COS + NPOS * 128;
      for (int i = gt; i < NPOS * 128; i += NGT) { const int pi = i >> 7, f = i & 127; const double pos = pi < SEQ ? (double)pi : (double)(PAST + pi - SEQ);
          const double inv = exp(-9.2103403719761827361 * (double)f / 127.0); double s, c; sincos_big(pos * inv, s, c); COS[i] = (float)c; SIN[i] = (float)s; } }
    { GAS bf16* LW = (GAS bf16*)(F.ws + WS_LRUW);
      for (int i = gt; i < 2 * 8 * 256 * 128; i += NGT) { const int k = i & 127, j2 = (i >> 7) & 255, en = i >> 15;
          const GAS float* src = (j2 < 128 ? F.inp(I_WA) : F.inp(I_WX)) + ((size_t)en * 128 + k) * 128 + (j2 & 127); LW[i] = (bf16)f2bf(*src); }
      GAS float* LC = (GAS float*)(F.ws + WS_LRUC);
      for (int i = gt; i < 2 * 1024; i += NGT) LC[i] = 8.0f * log1pf(expf(-F.inp(I_LAM)[i])); }
    { GAS bf16* BB = (GAS bf16*)(F.ws + WS_S5BB); GAS bf16* CM = (GAS bf16*)(F.ws + WS_S5CM); GAS float* AB = (GAS float*)(F.ws + WS_S5AB);
      for (int i = gt; i < 2 * SG * SP; i += NGT) { const int p = i & 63, g = (i >> 6) & 127, o = i >> 13;
          const double dt = exp((double)F.inp(I_LDT)[o * SG + g]), are = (double)F.inp(I_ARE)[i], aim = (double)F.inp(I_AIM)[i];
          double s, c; sincos_big(aim * dt, s, c); const double mag = exp(are * dt), abr = mag * c, abi = mag * s;
          double s2, c2; sincos_big(128.0 * aim * dt, s2, c2); const double mag2 = exp(128.0 * are * dt);
          const double den = are * are + aim * aim, nr = abr - 1.0, ni = abi, fr = (nr * are + ni * aim) / den, fi = (ni * are - nr * aim) / den;
          AB[(size_t)i * 4 + 0] = (float)abr; AB[(size_t)i * 4 + 1] = (float)abi; AB[(size_t)i * 4 + 2] = (float)(mag2 * c2); AB[(size_t)i * 4 + 3] = (float)(mag2 * s2);
          const GAS float* bre = F.inp(I_BRE) + (size_t)i * 16; const GAS float* bim = F.inp(I_BIM) + (size_t)i * 16;
          GAS bf16* bbr = BB + ((size_t)(o * SG + g) * 128 + 2 * p) * 16; GAS bf16* bbi = BB + ((size_t)(o * SG + g) * 128 + 2 * p + 1) * 16;
          for (int k = 0; k < 16; ++k) { const double br = bre[k], bi = bim[k]; bbr[k] = (bf16)f2bf((float)(fr * br - fi * bi)); bbi[k] = (bf16)f2bf((float)(fr * bi + fi * br)); }
          const GAS float* cre = F.inp(I_CRE) + (size_t)(o * SG + g) * 16 * 64; const GAS float* cim = F.inp(I_CIM) + (size_t)(o * SG + g) * 16 * 64;
          GAS bf16* cm = CM + (size_t)(o * SG + g) * 16 * 128;
          for (int k = 0; k < 16; ++k) { cm[k * 128 + 2 * p] = (bf16)f2bf(cre[k * 64 + p]); cm[k * 128 + 2 * p + 1] = (bf16)f2bf(-cim[k * 64 + p]); } }
      { GAS v2u* PW = (GAS v2u*)(F.ws + WS_S5PW);
        for (int it = gt; it < 2 * SG * SP * 8; it += NGT) { const int i = it >> 3, part = it & 7, p = i & 63, og = i >> 6;
            const double dt = exp((double)F.inp(I_LDT)[og]), are = (double)F.inp(I_ARE)[i], aim = (double)F.inp(I_AIM)[i];
            double s, c; sincos_big(aim * dt, s, c); const double mag = exp(are * dt), ar = mag * c, ai = mag * s;
            const double a2r = ar * ar - ai * ai, a2i = 2.0 * ar * ai, a3r = a2r * ar - a2i * ai, a3i = a2r * ai + a2i * ar, a4r = a2r * a2r - a2i * a2i, a4i = 2.0 * a2r * a2i;
            const double a8r = a4r * a4r - a4i * a4i, a8i = 2.0 * a4r * a4i, a16r = a8r * a8r - a8i * a8i, a16i = 2.0 * a8r * a8i;
            double wr = 1.0, wi = 0.0;
            for (int q = 0; q < part; ++q) { const double nr = wr * a16r - wi * a16i, ni = wr * a16i + wi * a16r; wr = nr; wi = ni; }
            for (int jj = 0; jj < 4; ++jj) { const int j = 4 * part + jj, sq = 31 - j, sub = sq >> 2, fq = sq & 3;
                const double p1r = wr * ar - wi * ai, p1i = wr * ai + wi * ar, p2r = wr * a2r - wi * a2i, p2i = wr * a2i + wi * a2r, p3r = wr * a3r - wi * a3i, p3i = wr * a3i + wi * a3r;
                const size_t idx = ((size_t)(og * 8 + sub) * 8 + (p >> 3)) * 64 + 16 * fq + 2 * (p & 7);
                v2u re, im; re.x = pk2((float)p3r, (float)p2r); re.y = pk2((float)p1r, (float)wr); im.x = pk2((float)p3i, (float)p2i); im.y = pk2((float)p1i, (float)wi);
                PW[idx] = re; PW[idx + 1] = im;
                const double nr = wr * a4r - wi * a4i, ni = wr * a4i + wi * a4r; wr = nr; wi = ni; } } } }
}
__device__ __forceinline__ float ret_log2g(int h) { return log2f(1.0f - exp2f(-5.0f - (float)h)); }

__device__ __forceinline__ void rot8(const v4u a, const v4u b, const GAS float* cs, const GAS float* sn, float sc, float (&o1)[8], float (&o2)[8]) {
    const f32x4 c0 = ((const GAS f32x4*)cs)[0], c1 = ((const GAS f32x4*)cs)[1], s0 = ((const GAS f32x4*)sn)[0], s1 = ((const GAS f32x4*)sn)[1];
    const float c[8] = {c0.x, c0.y, c0.z, c0.w, c1.x, c1.y, c1.z, c1.w}, s[8] = {s0.x, s0.y, s0.z, s0.w, s1.x, s1.y, s1.z, s1.w};
    const unsigned aw[4] = {a.x, a.y, a.z, a.w}, bw[4] = {b.x, b.y, b.z, b.w};
#pragma unroll
    for (int j = 0; j < 4; ++j) { const float x1l = bflo(aw[j]), x1h = bfhi(aw[j]), x2l = bflo(bw[j]), x2h = bfhi(bw[j]);
        o1[2 * j] = (x1l * c[2 * j] - x2l * s[2 * j]) * sc; o1[2 * j + 1] = (x1h * c[2 * j + 1] - x2h * s[2 * j + 1]) * sc;
        o2[2 * j] = (x2l * c[2 * j] + x1l * s[2 * j]) * sc; o2[2 * j + 1] = (x2h * c[2 * j + 1] + x1h * s[2 * j + 1]) * sc; }
}
__device__ __forceinline__ void ret_stage_rot_qk(const Frame& F, LAS unsigned char* qimg, LAS unsigned char* kimg, const GAS bf16* qsrc, const GAS bf16* ksrc, int pos0, float ksc) {
    const GAS float* COS = (const GAS float*)(F.ws + WS_ROPE); const GAS float* SIN = COS + NPOS * 128;
#pragma unroll 1
    for (int it0 = 0; it0 < 4; it0 += 2) {
        v4u qa[2], qb[2], ka[2], kb[2]; f32x4 c0[2], c1[2], s0[2], s1[2];
#pragma unroll
        for (int u = 0; u < 2; ++u) { const int item = F.tid + NTHR * (it0 + u), m = item >> 4, f8 = item & 15;
            const GAS bf16* qp = qsrc + (size_t)m * INW + 8 * f8; const GAS bf16* kp = ksrc + (size_t)m * INW + 8 * f8;
            qa[u] = *(const GAS v4u*)qp; qb[u] = *(const GAS v4u*)(qp + 128); ka[u] = *(const GAS v4u*)kp; kb[u] = *(const GAS v4u*)(kp + 128);
            const GAS float* cp = COS + (size_t)(pos0 + m) * 128 + 8 * f8; const GAS float* sp = SIN + (size_t)(pos0 + m) * 128 + 8 * f8;
            c0[u] = *(const GAS f32x4*)cp; c1[u] = *(const GAS f32x4*)(cp + 4); s0[u] = *(const GAS f32x4*)sp; s1[u] = *(const GAS f32x4*)(sp + 4); }
#pragma unroll
        for (int u = 0; u < 2; ++u) { const int item = F.tid + NTHR * (it0 + u), m = item >> 4, f8 = item & 15;
            const float c[8] = {c0[u].x, c0[u].y, c0[u].z, c0[u].w, c1[u].x, c1[u].y, c1[u].z, c1[u].w}, sn[8] = {s0[u].x, s0[u].y, s0[u].z, s0[u].w, s1[u].x, s1[u].y, s1[u].z, s1[u].w};
#pragma unroll
            for (int w = 0; w < 2; ++w) {
                const v4u a = w ? ka[u] : qa[u], b = w ? kb[u] : qb[u]; const float sc = w ? ksc : 1.0f;
                const unsigned aw[4] = {a.x, a.y, a.z, a.w}, bw[4] = {b.x, b.y, b.z, b.w}; unsigned o1[4], o2[4];
#pragma unroll
                for (int j = 0; j < 4; ++j) { const float x1l = bflo(aw[j]), x1h = bfhi(aw[j]), x2l = bflo(bw[j]), x2h = bfhi(bw[j]);
                    o1[j] = pk2((x1l * c[2 * j] - x2l * sn[2 * j]) * sc, (x1h * c[2 * j + 1] - x2h * sn[2 * j + 1]) * sc);
                    o2[j] = pk2((x2l * c[2 * j] + x1l * sn[2 * j]) * sc, (x2h * c[2 * j + 1] + x1h * sn[2 * j + 1]) * sc); }
                LAS unsigned char* img = w ? kimg : qimg; v4u w1, w2; w1.x = o1[0]; w1.y = o1[1]; w1.z = o1[2]; w1.w = o1[3]; w2.x = o2[0]; w2.y = o2[1]; w2.z = o2[2]; w2.w = o2[3];
                *(LAS v4u*)(img + m * 528 + 16 * f8) = w1; *(LAS v4u*)(img + m * 528 + 256 + 16 * f8) = w2; } }
    }
}
__device__ __forceinline__ void ret_stage_vT(const Frame& F, LAS unsigned char* img, const GAS bf16* src) {
    const int m = F.tid >> 2, e8l = F.tid & 3; v4u a[8];
#pragma unroll
    for (int it = 0; it < 8; ++it) a[it] = *(const GAS v4u*)(src + (size_t)m * INW + 8 * (e8l + 4 * it));
#pragma unroll
    for (int it = 0; it < 8; ++it) { const int e8 = e8l + 4 * it; const unsigned aw[4] = {a[it].x, a[it].y, a[it].z, a[it].w};
#pragma unroll
        for (int j = 0; j < 4; ++j) { *(LAS bf16*)(img + (8 * e8 + 2 * j) * 272 + 2 * m) = (bf16)(aw[j] & 0xffffu); *(LAS bf16*)(img + (8 * e8 + 2 * j + 1) * 272 + 2 * m) = (bf16)(aw[j] >> 16); } }
}

__device__ __forceinline__ void ret_scan_unit(const Frame& F, int e_layer, int b, int h, int dq, int eq) {
    const GAS bf16* PROJ = (const GAS bf16*)(F.ws + WS_PROJ);
    const GAS float* COS = (const GAS float*)(F.ws + WS_ROPE); const GAS float* SIN = COS + NPOS * 128;
    GAS bf16* SB = (GAS bf16*)(F.ws + WS_UT) + (size_t)(b * RH + h) * (NCH - 1) * 65536;
    const float lg2 = ret_log2g(h), dec = exp2f(128.0f * lg2);
    const int fr = F.lane & 15, fq = F.lane >> 4, db = F.wave >> 1, eb0 = 2 * (F.wave & 1);
    const int km = F.tid >> 2, kf4 = F.tid & 3, d1 = 32 * dq + 8 * kf4;
    const float ksc = 0.0625f * exp2f((float)(127 - km) * lg2);
    const GAS bf16* kp = PROJ + (size_t)(b * SEQ + km) * INW + 1024 + h * 256 + d1;
    const GAS float* cp = COS + (size_t)km * 128 + d1; const GAS float* sp = SIN + (size_t)km * 128 + d1;
    const GAS bf16* vp0 = PROJ + (size_t)(b * SEQ + km) * INW + 2048 + h * 256 + 64 * eq + 8 * kf4;
    v4u ka, kb, va, vb; f32x4 c0, c1, s0, s1;
    ka = *(const GAS v4u*)kp; kb = *(const GAS v4u*)(kp + 128); c0 = *(const GAS f32x4*)cp; c1 = *(const GAS f32x4*)(cp + 4); s0 = *(const GAS f32x4*)sp; s1 = *(const GAS f32x4*)(sp + 4);
    va = *(const GAS v4u*)vp0; vb = *(const GAS v4u*)(vp0 + 32);
    f32x4 acc[2] = {(f32x4){0.f, 0.f, 0.f, 0.f}, (f32x4){0.f, 0.f, 0.f, 0.f}};
    const int dl0 = 16 * db + 4 * fq, dg0 = dl0 < 32 ? 32 * dq + dl0 : 128 + 32 * dq + dl0 - 32;
    __syncthreads();
#pragma unroll 1
    for (int c = 0; c < NCH; ++c) {
        LAS unsigned char* KT = F.lds + (c & 1) * 34816; LAS unsigned char* VT = KT + 17408;
        if (c > 0) {
#pragma unroll
            for (int t = 0; t < 2; ++t) { v2u w; w.x = pk2(acc[t][0], acc[t][1]); w.y = pk2(acc[t][2], acc[t][3]);
                *(GAS v2u*)(SB + ((size_t)(c - 1) * 256 + 64 * eq + 16 * (eb0 + t) + fr) * 256 + dg0) = w; } }
        {
            const float cc[8] = {c0.x, c0.y, c0.z, c0.w, c1.x, c1.y, c1.z, c1.w}, ss[8] = {s0.x, s0.y, s0.z, s0.w, s1.x, s1.y, s1.z, s1.w};
            const unsigned aw[4] = {ka.x, ka.y, ka.z, ka.w}, bw[4] = {kb.x, kb.y, kb.z, kb.w};
#pragma unroll
            for (int j = 0; j < 8; ++j) { const float x1 = (j & 1) ? bfhi(aw[j >> 1]) : bflo(aw[j >> 1]), x2 = (j & 1) ? bfhi(bw[j >> 1]) : bflo(bw[j >> 1]);
                *(LAS bf16*)(KT + (8 * kf4 + j) * 272 + 2 * km) = (bf16)f2bf((x1 * cc[j] - x2 * ss[j]) * ksc);
                *(LAS bf16*)(KT + (32 + 8 * kf4 + j) * 272 + 2 * km) = (bf16)f2bf((x2 * cc[j] + x1 * ss[j]) * ksc); }
            const unsigned vw[8] = {va.x, va.y, va.z, va.w, vb.x, vb.y, vb.z, vb.w};
#pragma unroll
            for (int j = 0; j < 8; ++j) { const int e8 = kf4 + 4 * (j >> 2);
                *(LAS bf16*)(VT + (8 * e8 + 2 * (j & 3)) * 272 + 2 * km) = (bf16)(vw[j] & 0xffffu); *(LAS bf16*)(VT + (8 * e8 + 2 * (j & 3) + 1) * 272 + 2 * km) = (bf16)(vw[j] >> 16); }
        }
        if (c + 1 < NCH) {
            const size_t ro = (size_t)(c + 1) * CH * INW; const size_t po = (size_t)(c + 1) * CH * 128;
            ka = *(const GAS v4u*)(kp + ro); kb = *(const GAS v4u*)(kp + ro + 128); c0 = *(const GAS f32x4*)(cp + po); c1 = *(const GAS f32x4*)(cp + po + 4); s0 = *(const GAS f32x4*)(sp + po); s1 = *(const GAS f32x4*)(sp + po + 4);
            va = *(const GAS v4u*)(vp0 + ro); vb = *(const GAS v4u*)(vp0 + ro + 32); }
        asm volatile("s_waitcnt lgkmcnt(0)" ::: "memory"); __builtin_amdgcn_s_barrier(); asm volatile("" ::: "memory");
        acc[0] = acc[0] * dec; acc[1] = acc[1] * dec;
#pragma unroll
        for (int ks = 0; ks < 4; ++ks) { const bf16x8 af = *(const LAS bf16x8*)(KT + (16 * db + fr) * 272 + (32 * ks + 8 * fq) * 2);
#pragma unroll
            for (int t = 0; t < 2; ++t) { const bf16x8 bv = *(const LAS bf16x8*)(VT + (16 * (eb0 + t) + fr) * 272 + (32 * ks + 8 * fq) * 2); acc[t] = MFMA32(af, bv, acc[t]); } }
    }
    GAS float* o = F.out + O_RETP + (size_t)((e_layer * BATCH + b) * RH + h) * 65536;
#pragma unroll
    for (int t = 0; t < 2; ++t)
#pragma unroll
        for (int r = 0; r < 4; ++r) o[(size_t)(dg0 + r) * 256 + 64 * eq + 16 * (eb0 + t) + fr] = acc[t][r];
}

__device__ __forceinline__ void ret_c_unit(const Frame& F, int b, int h, int c) {
    LAS unsigned char* QS = F.lds; LAS unsigned char* R2 = F.lds + 67584;
    const GAS bf16* PROJ = (const GAS bf16*)(F.ws + WS_PROJ); const int row0 = b * SEQ + CH * c;
    const float lg2 = ret_log2g(h);
    __syncthreads();
    ret_stage_rot_qk(F, QS, R2, PROJ + (size_t)row0 * INW + h * 256, PROJ + (size_t)row0 * INW + 1024 + h * 256, CH * c, 0.0625f);
    __syncthreads();
    const int fr = F.lane & 15, fq = F.lane >> 4, w = F.wave;
    const int nl = 16 * w + fr;
    bf16x8 pf[4];
    { f32x4 ap[8];
#pragma unroll
      for (int mb = 0; mb < 8; ++mb) ap[mb] = (f32x4){0.f, 0.f, 0.f, 0.f};
#pragma unroll
      for (int ks = 0; ks < 8; ++ks) { const bf16x8 qf = *(const LAS bf16x8*)(QS + nl * 528 + (32 * ks + 8 * fq) * 2);
#pragma unroll
          for (int mb = 0; mb < 8; ++mb) { const bf16x8 kf = *(const LAS bf16x8*)(R2 + (16 * mb + fr) * 528 + (32 * ks + 8 * fq) * 2); ap[mb] = MFMA32(kf, qf, ap[mb]); }
          __builtin_amdgcn_sched_barrier(0); }
#pragma unroll
      for (int mb = 0; mb < 8; ++mb)
#pragma unroll
          for (int r = 0; r < 4; ++r) { const int m = 16 * mb + 4 * fq + r, df = nl - m; ap[mb][r] = df >= 0 ? ap[mb][r] * exp2f((float)df * lg2) : 0.f; }
#pragma unroll
      for (int s = 0; s < 4; ++s) { v4u t; t.x = pk2(ap[2 * s][0], ap[2 * s][1]); t.y = pk2(ap[2 * s][2], ap[2 * s][3]); t.z = pk2(ap[2 * s + 1][0], ap[2 * s + 1][1]); t.w = pk2(ap[2 * s + 1][2], ap[2 * s + 1][3]);
          pf[s] = __builtin_bit_cast(bf16x8, t); }
      asm volatile("" : "+v"(pf[0]), "+v"(pf[1]), "+v"(pf[2]), "+v"(pf[3])); }
    f32x4 acc[16];
#pragma unroll
    for (int eb = 0; eb < 16; ++eb) acc[eb] = (f32x4){0.f, 0.f, 0.f, 0.f};
#ifndef RC_NO_S
    if (c > 0) {
        const GAS bf16* SB = (const GAS bf16*)(F.ws + WS_UT) + ((size_t)(b * RH + h) * (NCH - 1) + c - 1) * 65536;
#pragma unroll
        for (int half = 0; half < 2; ++half) {
            __syncthreads();
            { const GAS bf16* sp = SB + (size_t)(128 * half + (F.tid >> 5)) * 256 + 8 * (F.tid & 31); LAS unsigned char* dp = R2 + (F.tid >> 5) * 528 + 16 * (F.tid & 31);
#pragma unroll 1
              for (int ih = 0; ih < 2; ++ih) { v4u t[4];
#pragma unroll
                  for (int it = 0; it < 4; ++it) t[it] = *(const GAS v4u*)(sp + (size_t)(16 * (4 * ih + it)) * 256);
#pragma unroll
                  for (int it = 0; it < 4; ++it) *(LAS v4u*)(dp + 16 * (4 * ih + it) * 528) = t[it]; } }
            __syncthreads();
#pragma unroll
            for (int ks = 0; ks < 8; ++ks) { const bf16x8 qf = *(const LAS bf16x8*)(QS + nl * 528 + (32 * ks + 8 * fq) * 2);
#pragma unroll
                for (int eb = 0; eb < 8; ++eb) { const bf16x8 sf = *(const LAS bf16x8*)(R2 + (16 * eb + fr) * 528 + (32 * ks + 8 * fq) * 2); acc[8 * half + eb] = MFMA32(sf, qf, acc[8 * half + eb]); }
                __builtin_amdgcn_sched_barrier(0); }
            asm volatile("" : "+v"(acc[8 * half + 0]), "+v"(acc[8 * half + 1]), "+v"(acc[8 * half + 2]), "+v"(acc[8 * half + 3]), "+v"(acc[8 * half + 4]), "+v"(acc[8 * half + 5]), "+v"(acc[8 * half + 6]), "+v"(acc[8 * half + 7]));
        }
        const float qd = exp2f((float)(nl + 1) * lg2);
#pragma unroll
        for (int eb = 0; eb < 16; ++eb) acc[eb] = acc[eb] * qd;
    }
#endif
#ifndef RC_NO_PV
    __syncthreads();
    ret_stage_vT(F, R2, PROJ + (size_t)row0 * INW + 2048 + h * 256);
    __syncthreads();
#pragma unroll
    for (int s = 0; s < 4; ++s)
#pragma unroll
        for (int eh = 0; eh < 2; ++eh) {
#pragma unroll
            for (int e8 = 0; e8 < 8; ++e8) { const int eb = 8 * eh + e8; const LAS unsigned char* vp = R2 + (16 * eb + fr) * 272 + (32 * s + 4 * fq) * 2;
                const v2u lo = *(const LAS v2u*)vp, hi = *(const LAS v2u*)(vp + 32); v4u t; t.x = lo.x; t.y = lo.y; t.z = hi.x; t.w = hi.y;
                acc[eb] = MFMA32(__builtin_bit_cast(bf16x8, t), pf[s], acc[eb]); }
            __builtin_amdgcn_sched_barrier(0); }
#endif
    float ss = 0.f;
#pragma unroll
    for (int eb = 0; eb < 16; ++eb) ss += (acc[eb][0] * acc[eb][0] + acc[eb][1] * acc[eb][1]) + (acc[eb][2] * acc[eb][2] + acc[eb][3] * acc[eb][3]);
    ss += __shfl_xor(ss, 16); ss += __shfl_xor(ss, 32);
    const float rstd = 1.0f / sqrtf(ss * (1.0f / 256.0f) + EPS);
    const GAS bf16* grp = PROJ + (size_t)(row0 + nl) * INW + 3072 + h * 256 + 4 * fq; GAS bf16* op = (GAS bf16*)(F.ws + WS_CAT) + (size_t)(row0 + nl) * D + h * 256 + 4 * fq;
    v2u gv[16];
#pragma unroll
    for (int eb = 0; eb < 16; ++eb) gv[eb] = *(const GAS v2u*)(grp + 16 * eb);
#pragma unroll
    for (int eb = 0; eb < 16; ++eb) { const v2u g = gv[eb];
        v2u o; o.x = pk2(acc[eb][0] * rstd * siluf_(bflo(g.x)), acc[eb][1] * rstd * siluf_(bfhi(g.x))); o.y = pk2(acc[eb][2] * rstd * siluf_(bflo(g.y)), acc[eb][3] * rstd * siluf_(bfhi(g.y)));
        *(GAS v2u*)(op + 16 * eb) = o; }
}

template <int PM>
__device__ __forceinline__ void ret_s_unit(const Frame& F, int e_layer, int b, int h) {
    LAS float* QK = (LAS float*)F.lds;
    LAS float* VS = QK + 2048;
    LAS float* SC = VS + 1024;
    LAS float* RED = SC + 16;
    LAS float* OS = RED + 8192;
    LAS float* NRM = OS + 1024;
    const GAS bf16* PROJ = (const GAS bf16*)(F.ws + WS_PROJ); const int row0 = MP + b * DEC_T;
    const GAS float* COS = (const GAS float*)(F.ws + WS_ROPE); const GAS float* SIN = COS + NPOS * 128;
    const float lg2 = ret_log2g(h);
    __syncthreads();
    {
#pragma unroll
      for (int it = 0; it < 2; ++it) { const int item = F.tid + NTHR * it, f = item & 127, t = (item >> 7) & 3, isk = item >> 9;
          const GAS bf16* p = PROJ + (size_t)(row0 + t) * INW + isk * 1024 + h * 256; const float x1 = bf2f(p[f]), x2 = bf2f(p[128 + f]);
          const float c = COS[(SEQ + t) * 128 + f], s = SIN[(SEQ + t) * 128 + f]; float sc = isk ? 0.0625f * exp2f((float)(3 - t) * lg2) : 1.0f;
          QK[f * 8 + isk * 4 + t] = (x1 * c - x2 * s) * sc; QK[(128 + f) * 8 + isk * 4 + t] = (x2 * c + x1 * s) * sc; }
#pragma unroll
      for (int it = 0; it < 2; ++it) { const int item = F.tid + NTHR * it, e = item & 255, t = item >> 8; VS[t * 256 + e] = bf2f(PROJ[(size_t)(row0 + t) * INW + 2048 + h * 256 + e]); }
    }
    __syncthreads();
    { const int pr = F.tid >> 5, n = pr >> 2, m = pr & 3, l32 = F.tid & 31; float s = 0.f;
#pragma unroll
      for (int j = 0; j < 8; ++j) { const int d = l32 + 32 * j; s += QK[d * 8 + n] * QK[d * 8 + 4 + m]; }
#pragma unroll
      for (int o = 1; o < 32; o <<= 1) s += __shfl_xor(s, o);
      if (l32 == 0) { s *= exp2f(-(float)(3 - m) * lg2); SC[n * 4 + m] = n >= m ? s * exp2f((float)(n - m) * lg2) : 0.f; } }
    const int eg = F.tid & 63, dg = F.tid >> 6;
    const GAS float* s0 = F.inp(I_SRET) + ((size_t)(e_layer * DEC_B + b) * RH + h) * 65536;
    GAS float* s1 = F.out + O_RETS + ((size_t)(e_layer * DEC_B + b) * RH + h) * 65536;
    const float dec = exp2f(4.0f * lg2);
    f32x4 v[4], oa[4];
#pragma unroll
    for (int m = 0; m < 4; ++m) { v[m] = *(const LAS f32x4*)(VS + m * 256 + 4 * eg); oa[m] = (f32x4){0.f, 0.f, 0.f, 0.f}; }
    if (PM != 1)
    {
        f32x4 ring[8];
#pragma unroll
        for (int j = 0; j < 8; ++j) ring[j] = __builtin_nontemporal_load((const GAS f32x4*)(s0 + (size_t)(32 * dg + j) * 256 + 4 * eg));
#pragma unroll 1
        for (int bt = 0; bt < 4; ++bt) { const int d0 = 32 * dg + 8 * bt; const int dn = bt < 3 ? d0 + 8 : d0;
#pragma unroll
            for (int j = 0; j < 8; ++j) { const int d = d0 + j; const f32x4 st = ring[j];
                const f32x4 q = *(const LAS f32x4*)(QK + d * 8), k = *(const LAS f32x4*)(QK + d * 8 + 4);
                oa[0] += st * q.x; oa[1] += st * q.y; oa[2] += st * q.z; oa[3] += st * q.w;
                const f32x4 sn = st * dec + v[0] * k.x + v[1] * k.y + v[2] * k.z + v[3] * k.w;
                __builtin_nontemporal_store(sn, (GAS f32x4*)(s1 + (size_t)d * 256 + 4 * eg));
                ring[j] = __builtin_nontemporal_load((const GAS f32x4*)(s0 + (size_t)(dn + j) * 256 + 4 * eg)); } }
    }
#pragma unroll
    for (int n = 0; n < 4; ++n) *(LAS f32x4*)(RED + (dg * 4 + n) * 256 + 4 * eg) = oa[n];
    __syncthreads();
    {
#pragma unroll
      for (int it = 0; it < 2; ++it) { const int item = F.tid + NTHR * it, e = item & 255, n = item >> 8; float s = 0.f;
#pragma unroll
          for (int g8 = 0; g8 < 8; ++g8) s += RED[(g8 * 4 + n) * 256 + e];
          s *= exp2f((float)(n + 1) * lg2);
#pragma unroll
          for (int m = 0; m < 4; ++m) s += SC[n * 4 + m] * VS[m * 256 + e];
          OS[n * 256 + e] = s; } }
    __syncthreads();
    if (F.wave < 4) { const int n = F.wave; float ss = 0.f;
#pragma unroll
        for (int j = 0; j < 4; ++j) { const float x = OS[n * 256 + F.lane + 64 * j]; ss += x * x; }
        ss = wave_sum(ss); if (F.lane == 0) NRM[n] = 1.0f / sqrtf(ss * (1.0f / 256.0f) + EPS); }
    __syncthreads();
#pragma unroll
    for (int it = 0; it < 2; ++it) { const int item = F.tid + NTHR * it, e = item & 255, n = item >> 8;
        const float g = bf2f(PROJ[(size_t)(row0 + n) * INW + 3072 + h * 256 + e]);
        ((GAS bf16*)(F.ws + WS_CAT))[(size_t)(row0 + n) * D + h * 256 + e] = (bf16)f2bf(OS[n * 256 + e] * NRM[n] * siluf_(g)); }
}
template <int MODE>
__device__ __forceinline__ void lru_unit(const Frame& F, int e_layer, int tile_b, int tile_c, int n, bool stage_w) {
    LAS unsigned char* XC = F.lds;
    LAS unsigned char* WT = F.lds + 34816;
    const GAS bf16* PROJ = (const GAS bf16*)(F.ws + WS_PROJ);
    const int row0 = MODE == 2 ? MP + 128 * tile_c : tile_b * SEQ + CH * tile_c;
    __syncthreads();
    if (stage_w) { const GAS bf16* LW = (const GAS bf16*)(F.ws + WS_LRUW) + (size_t)(e_layer * 8 + n) * 256 * 128; v4u t[8];
#pragma unroll
      for (int it = 0; it < 8; ++it) { const int item = F.tid + NTHR * it, r = item >> 4, c16 = item & 15; t[it] = *(const GAS v4u*)(LW + r * 128 + 8 * c16); }
#pragma unroll
      for (int it = 0; it < 8; ++it) { const int item = F.tid + NTHR * it, r = item >> 4, c16 = item & 15; *(LAS v4u*)(WT + r * 272 + 16 * c16) = t[it]; } }
    { const int c8 = F.tid & 15;
      const GAS float* cw = F.inp(I_CW) + (size_t)e_layer * 4 * LRU_W + n * 128 + 8 * c8; const GAS float* cb = F.inp(I_CB) + (size_t)e_layer * LRU_W + n * 128 + 8 * c8;
      float wv[4][8], bias[8];
      { const f32x4 b0 = *(const GAS f32x4*)cb, b1 = *(const GAS f32x4*)(cb + 4); bias[0] = b0.x; bias[1] = b0.y; bias[2] = b0.z; bias[3] = b0.w; bias[4] = b1.x; bias[5] = b1.y; bias[6] = b1.z; bias[7] = b1.w; }
#pragma unroll
      for (int kk = 0; kk < 4; ++kk) { const f32x4 w0 = *(const GAS f32x4*)(cw + (3 - kk) * LRU_W), w1 = *(const GAS f32x4*)(cw + (3 - kk) * LRU_W + 4);
          wv[kk][0] = w0.x; wv[kk][1] = w0.y; wv[kk][2] = w0.z; wv[kk][3] = w0.w; wv[kk][4] = w1.x; wv[kk][5] = w1.y; wv[kk][6] = w1.z; wv[kk][7] = w1.w; }
#pragma unroll 1
      for (int ih = 0; ih < 2; ++ih) {
      v4u xr[2][4];
#pragma unroll
      for (int it = 0; it < 2; ++it) { const int tok = (F.tid >> 4) + 32 * (2 * ih + it);
#pragma unroll
          for (int kk = 0; kk < 4; ++kk) { const int tq = MODE == 2 ? (tok & 3) - kk : CH * tile_c + tok - kk;
              xr[it][kk] = (v4u){0u, 0u, 0u, 0u};
              if (tq >= 0) xr[it][kk] = *(const GAS v4u*)(PROJ + (size_t)(row0 + tok - kk) * INW + 4096 + n * 128 + 8 * c8); } }
#pragma unroll
      for (int it = 0; it < 2; ++it) { const int tok = (F.tid >> 4) + 32 * (2 * ih + it);
          float acc[8];
#pragma unroll
          for (int j = 0; j < 8; ++j) acc[j] = bias[j];
#pragma unroll
          for (int kk = 0; kk < 4; ++kk) { const v4u a = xr[it][kk]; float x[8] = {bflo(a.x), bfhi(a.x), bflo(a.y), bfhi(a.y), bflo(a.z), bfhi(a.z), bflo(a.w), bfhi(a.w)};
              if (MODE == 2) { const int tq = (tok & 3) - kk;
                  if (tq < 0) { const int bb = 32 * tile_c + (tok >> 2); const GAS float* sp = F.inp(I_SCONV) + ((size_t)(e_layer * DEC_B + bb) * 3 + (3 + tq)) * LRU_W + n * 128 + 8 * c8;
                      const f32x4 s0 = *(const GAS f32x4*)sp, s1 = *(const GAS f32x4*)(sp + 4); x[0] = s0.x; x[1] = s0.y; x[2] = s0.z; x[3] = s0.w; x[4] = s1.x; x[5] = s1.y; x[6] = s1.z; x[7] = s1.w; } }
#pragma unroll
              for (int j = 0; j < 8; ++j) acc[j] += x[j] * wv[kk][j]; }
          v4u o; o.x = pk2(acc[0], acc[1]); o.y = pk2(acc[2], acc[3]); o.z = pk2(acc[4], acc[5]); o.w = pk2(acc[6], acc[7]);
          *(LAS v4u*)(XC + tok * 272 + 16 * c8) = o; } } }
    __syncthreads();
    const int fr = F.lane & 15, fq = F.lane >> 4, w = F.wave;
    f32x4 aR[8], aI[8];
#pragma unroll
    for (int tb = 0; tb < 8; ++tb) { aR[tb] = (f32x4){0.f, 0.f, 0.f, 0.f}; aI[tb] = (f32x4){0.f, 0.f, 0.f, 0.f}; }
#pragma unroll
    for (int ks = 0; ks < 4; ++ks) {
        const bf16x8 br = *(const LAS bf16x8*)(WT + (16 * w + fr) * 272 + (32 * ks + 8 * fq) * 2), bi = *(const LAS bf16x8*)(WT + (128 + 16 * w + fr) * 272 + (32 * ks + 8 * fq) * 2);
#pragma unroll
        for (int tb = 0; tb < 8; ++tb) { const bf16x8 af = *(const LAS bf16x8*)(XC + (16 * tb + fr) * 272 + (32 * ks + 8 * fq) * 2);
            aR[tb] = MFMA32(af, br, aR[tb]); aI[tb] = MFMA32(af, bi, aI[tb]); }
    }
    const int chl = 16 * w + fr, ch = n * 128 + chl;
    const float cc = ((const GAS float*)(F.ws + WS_LRUC))[e_layer * LRU_W + ch], ba = F.inp(I_BA)[e_layer * LRU_W + ch], bx = F.inp(I_BX)[e_layer * LRU_W + ch];
    float H = 0.f, Aprod = 1.f;
    if (MODE == 1) {
        const GAS float* SA = (const GAS float*)(F.ws + WS_LSA) + (size_t)tile_b * NCH * LRU_W + ch; const GAS float* SBm = (const GAS float*)(F.ws + WS_LSB) + (size_t)tile_b * NCH * LRU_W + ch;
        float av[NCH - 1], bv[NCH - 1];
#pragma unroll
        for (int cc = 0; cc < NCH - 1; ++cc) { av[cc] = 1.f; bv[cc] = 0.f; if (cc < tile_c) { av[cc] = SA[(size_t)cc * LRU_W]; bv[cc] = SBm[(size_t)cc * LRU_W]; } }
#pragma unroll
        for (int cc = 0; cc < NCH - 1; ++cc) H = av[cc] * H + bv[cc]; }
    GAS bf16* CAT = (GAS bf16*)(F.ws + WS_CAT);
    bf16 yln[4] = {0, 0, 0, 0};
    if (MODE != 0) {
#pragma unroll
        for (int r = 0; r < 4; ++r) yln[r] = PROJ[(size_t)(row0 + 4 * fq + r) * INW + 5120 + ch]; }
#pragma unroll
    for (int tb = 0; tb < 8; ++tb) {
        bf16 ylc[4];
#pragma unroll
        for (int r = 0; r < 4; ++r) ylc[r] = yln[r];
        if (MODE != 0 && tb < 7) {
#pragma unroll
            for (int r = 0; r < 4; ++r) yln[r] = PROJ[(size_t)(row0 + 16 * (tb + 1) + 4 * fq + r) * INW + 5120 + ch]; }
        float a[4], bt[4];
#pragma unroll
        for (int r = 0; r < 4; ++r) { const int tok = 16 * tb + 4 * fq + r;
            const float rr = sigmoidf_(aR[tb][r] + ba), ii = sigmoidf_(aI[tb][r] + bx), la = -cc * rr;
            a[r] = __builtin_amdgcn_exp2f(1.44269504f * la); const float m2 = 1.0f - a[r] * a[r];
            const float x = bf2f(*(const LAS bf16*)(XC + tok * 272 + 2 * chl));
            bt[r] = sqrtf(fmaxf(m2, 0.f)) * ii * x; }
        if (MODE == 2) {
            const int bb = 32 * tile_c + 4 * tb + fq; float h = F.inp(I_SLRU)[(size_t)(e_layer * DEC_B + bb) * LRU_W + ch];
#pragma unroll
            for (int r = 0; r < 4; ++r) { h = a[r] * h + bt[r]; const size_t row = (size_t)(row0 + 16 * tb + 4 * fq + r);
                const float yl = bf2f(ylc[r]); CAT[row * D + 1024 + ch] = (bf16)f2bf(geluf_(yl) * h); }
            F.out[O_LRUS + (size_t)(e_layer * DEC_B + bb) * LRU_W + ch] = h;
        } else {
            float As = a[0], Bs = bt[0];
#pragma unroll
            for (int r = 1; r < 4; ++r) { Bs = a[r] * Bs + bt[r]; As *= a[r]; }
            float Ai = As, Bi = Bs;
            { const float A1 = __shfl_up(Ai, 16), B1 = __shfl_up(Bi, 16); if (fq >= 1) { Bi = Ai * B1 + Bi; Ai = Ai * A1; } }
            { const float A2 = __shfl_up(Ai, 32), B2 = __shfl_up(Bi, 32); if (fq >= 2) { Bi = Ai * B2 + Bi; Ai = Ai * A2; } }
            float Ae = __shfl_up(Ai, 16), Be = __shfl_up(Bi, 16); if (fq == 0) { Ae = 1.f; Be = 0.f; }
            const float At = __shfl(Ai, 48 + fr), Bt = __shfl(Bi, 48 + fr);
            if (MODE == 1) { float h = Ae * H + Be;
#pragma unroll
                for (int r = 0; r < 4; ++r) { h = a[r] * h + bt[r]; const size_t row = (size_t)(row0 + 16 * tb + 4 * fq + r);
                    const float yl = bf2f(ylc[r]); CAT[row * D + 1024 + ch] = (bf16)f2bf(geluf_(yl) * h); } }
            H = At * H + Bt; Aprod *= At;
        }
    }
    if (MODE == 1 && tile_c == NCH - 1 && fq == 0) F.out[O_LRUP + (size_t)(e_layer * BATCH + tile_b) * LRU_W + ch] = H;
    if (MODE == 0 && fq == 0) { ((GAS float*)(F.ws + WS_LSA))[(size_t)(tile_b * NCH + tile_c) * LRU_W + ch] = Aprod; ((GAS float*)(F.ws + WS_LSB))[(size_t)(tile_b * NCH + tile_c) * LRU_W + ch] = H; }
    if (MODE == 2) {
#pragma unroll 1
        for (int it = 0; it < 24; ++it) { const int item = F.tid + NTHR * it, chx = item & 127, i3 = (item >> 7) % 3, bl = item / 384;
            const int bb = 32 * tile_c + bl; F.out[O_CONVS + ((size_t)(e_layer * DEC_B + bb) * 3 + i3) * LRU_W + n * 128 + chx] = bf2f(PROJ[(size_t)(MP + bb * 4 + 1 + i3) * INW + 4096 + n * 128 + chx]); }
    } else if (MODE == 1 && tile_c == NCH - 1) {
        if (F.tid < 384) { const int chx = F.tid & 127, i3 = F.tid >> 7;
            F.out[O_CONVP + ((size_t)(e_layer * BATCH + tile_b) * 3 + i3) * LRU_W + n * 128 + chx] = bf2f(PROJ[(size_t)(tile_b * SEQ + SEQ - 3 + i3) * INW + 4096 + n * 128 + chx]); }
    }
}
template <int MODE>
__device__ __forceinline__ void s5_wave_unit(const Frame& F, int o_layer, int pb, int pc, int g) {
    LAS float* BU = (LAS float*)(F.lds + F.wave * 12800);
    LAS unsigned char* SS = F.lds + F.wave * 12800 + 8448;
    const int lane = F.lane, fr = lane & 15, fq = lane >> 4;
    const GAS bf16* XN = (const GAS bf16*)(F.ws + WS_XN); GAS bf16* CAT = (GAS bf16*)(F.ws + WS_CAT);
    const GAS bf16* BB = (const GAS bf16*)(F.ws + WS_S5BB) + (size_t)(o_layer * SG + g) * 128 * 16;
    const GAS bf16* CM = (const GAS bf16*)(F.ws + WS_S5CM) + (size_t)(o_layer * SG + g) * 16 * 128;
    bf16x4 bb[8];
#pragma unroll
    for (int nb = 0; nb < 8; ++nb) bb[nb] = __builtin_bit_cast(bf16x4, *(const GAS v2u*)(BB + (16 * nb + fr) * 16 + 4 * fq));
    bf16x8 cm[4]; f32x4 dd = (f32x4){0.f, 0.f, 0.f, 0.f};
    if (MODE != 0) {
#pragma unroll
        for (int ks = 0; ks < 4; ++ks) cm[ks] = __builtin_bit_cast(bf16x8, *(const GAS v4u*)(CM + fr * 128 + 32 * ks + 8 * fq));
        dd = *(const GAS f32x4*)(F.inp(I_SD) + (size_t)o_layer * D + 16 * g + 4 * fq); }
    const f32x4 ab = *(const GAS f32x4*)((const GAS float*)(F.ws + WS_S5AB) + (size_t)((o_layer * SG + g) * SP + lane) * 4);
    const float ar = ab.x, ai = ab.y;
    float sr = 0.f, si = 0.f;
    GAS float* LOC = (GAS float*)(F.ws + WS_S5LOC);
    if (MODE == 1) {
        const float a8r = ab.z, a8i = ab.w; const GAS f32x2* lp = (const GAS f32x2*)(LOC + ((size_t)pb * NCH * 8192 + g * SP + lane) * 2);
        f32x2 lv[NCH - 1];
#pragma unroll
        for (int cc = 0; cc < NCH - 1; ++cc) { lv[cc] = (f32x2){0.f, 0.f}; if (cc < pc) lv[cc] = lp[(size_t)cc * 8192]; }
#pragma unroll
        for (int cc = 0; cc < NCH - 1; ++cc) if (cc < pc) { const float nr = a8r * sr - a8i * si + lv[cc].x, ni = a8r * si + a8i * sr + lv[cc].y; sr = nr; si = ni; } }
    constexpr int nsub = MODE == 2 ? 1 : 8;
    const int rowbase = MODE == 2 ? MP + 16 * pc : pb * SEQ + CH * pc;
    v2u uall[nsub], oall[nsub];
#pragma unroll
    for (int sub = 0; sub < nsub; ++sub) uall[sub] = *(const GAS v2u*)(XN + (size_t)(rowbase + 16 * sub + fr) * D + 16 * g + 4 * fq);
#pragma unroll
    for (int sub = 0; sub < nsub; ++sub) {
        const int r0 = rowbase + 16 * sub;
        const v2u uraw = uall[sub];
        const bf16x4 uf = __builtin_bit_cast(bf16x4, uraw);
#pragma unroll
        for (int nb = 0; nb < 8; ++nb) { const f32x4 d = MFMA16(bb[nb], uf, ((f32x4){0.f, 0.f, 0.f, 0.f}));
            *(LAS f32x4*)(BU + fr * 132 + 16 * nb + 4 * fq) = d; }
        float isr[4], isi[4];
        if (MODE == 2) {
#pragma unroll
            for (int q = 0; q < 4; ++q) { const size_t si0 = ((size_t)(o_layer * DEC_B + 4 * pc + q) * SG + g) * SP + lane; isr[q] = F.inp(I_SSRE)[si0]; isi[q] = F.inp(I_SSIM)[si0]; } }
        float br[16], bi[16];
#pragma unroll
        for (int t = 0; t < 16; ++t) { const f32x2 bv = *(const LAS f32x2*)(BU + t * 132 + 2 * lane); br[t] = bv.x; bi[t] = bv.y; }
#pragma unroll
        for (int t = 0; t < 16; ++t) {
            if (MODE == 2 && (t & 3) == 0) { sr = isr[t >> 2]; si = isi[t >> 2]; }
            const float nr = ar * sr - ai * si + br[t], ni = ar * si + ai * sr + bi[t]; sr = nr; si = ni;
            if (MODE != 0) *(LAS u32a*)(SS + t * 272 + 4 * lane) = pk2(sr, si);
            if (MODE == 2 && (t & 3) == 3) { const int bbt = 4 * pc + (t >> 2); const size_t so = ((size_t)(o_layer * DEC_B + bbt) * SG + g) * SP + lane; F.out[O_SRES + so] = sr; F.out[O_SIMS + so] = si; }
        }
        if (MODE != 0) {
            f32x4 y = (f32x4){0.f, 0.f, 0.f, 0.f};
#pragma unroll
            for (int ks = 0; ks < 4; ++ks) { const bf16x8 sf = *(const LAS bf16x8*)(SS + fr * 272 + (32 * ks + 8 * fq) * 2); y = MFMA32(cm[ks], sf, y); }
            const float u0 = bflo(uraw.x), u1 = bfhi(uraw.x), u2 = bflo(uraw.y), u3 = bfhi(uraw.y);
            v2u o; o.x = pk2(geluf_(y[0] + dd.x * u0), geluf_(y[1] + dd.y * u1)); o.y = pk2(geluf_(y[2] + dd.z * u2), geluf_(y[3] + dd.w * u3));
            oall[sub] = o;
        }
    }
    if (MODE != 0) {
#pragma unroll
        for (int sub = 0; sub < nsub; ++sub) *(GAS v2u*)(CAT + (size_t)(rowbase + 16 * sub + fr) * D + 16 * g + 4 * fq) = oall[sub]; }
    if (MODE == 0) *(GAS f32x2*)(LOC + ((size_t)(pb * NCH + pc) * 8192 + g * SP + lane) * 2) = (f32x2){sr, si};
    if (MODE == 1 && pc == NCH - 1) { const size_t so = (size_t)(o_layer * BATCH + pb) * 8192 + g * SP + lane; F.out[O_SREP + so] = sr; F.out[O_SIMP + so] = si; }
}

#define SWZX(x, pat) __builtin_bit_cast(float, __builtin_amdgcn_ds_swizzle(__builtin_bit_cast(int, (x)), (pat)))
__device__ __forceinline__ void s5_end_units(const Frame& F, int o_layer, int g, int half, int piece0, int pstep) {
    const int lane = F.lane, fr = lane & 15, fq = lane >> 4;
    const GAS bf16* XN = (const GAS bf16*)(F.ws + WS_XN);
    const GAS v2u* T = (const GAS v2u*)(F.ws + WS_S5PW) + ((size_t)(o_layer * SG + g) * 64 + 4 * half) * 64 + lane;
    bf16x4 tab[8][4];
#pragma unroll
    for (int sub = 0; sub < 8; ++sub)
#pragma unroll
        for (int mb = 0; mb < 4; ++mb) tab[sub][mb] = __builtin_bit_cast(bf16x4, T[(size_t)(sub * 8 + mb) * 64]);
    const GAS bf16* BB = (const GAS bf16*)(F.ws + WS_S5BB) + (size_t)(o_layer * SG + g) * 128 * 16;
    float bre[8], bim[8];
#pragma unroll
    for (int j = 0; j < 8; ++j) { const int p = 8 * (4 * half + (j >> 1)) + 2 * fq + (j & 1);
        bre[j] = __builtin_bit_cast(float, (unsigned)BB[(2 * p) * 16 + fr] << 16); bim[j] = __builtin_bit_cast(float, (unsigned)BB[(2 * p + 1) * 16 + fr] << 16); }
    v2u idw; { const int d = fr - 4 * fq; idw.x = d == 0 ? 0x3F80u : d == 1 ? 0x3F800000u : 0u; idw.y = d == 2 ? 0x3F80u : d == 3 ? 0x3F800000u : 0u; }
    const bf16x4 ident = __builtin_bit_cast(bf16x4, idw);
    GAS float* LOC = (GAS float*)(F.ws + WS_S5LOC);
    v2u ub[3][8];
#define S5E_LOADU(buf, pcx) { const int rb_ = ((pcx) >> 4) * SEQ + CH * ((pcx) & 15); _Pragma("unroll") for (int sub = 0; sub < 8; ++sub) buf[sub] = *(const GAS v2u*)(XN + (size_t)(rb_ + 16 * sub + fr) * D + 16 * g + 4 * fq); }
    S5E_LOADU(ub[0], piece0); S5E_LOADU(ub[1], piece0 + pstep);
#pragma unroll
    for (int it = 0; it < 8; ++it) { const int pc = piece0 + pstep * it;
        if (it + 2 < 8) S5E_LOADU(ub[(it + 2) % 3], piece0 + pstep * (it + 2));
        v2u (&uall)[8] = ub[it % 3];
        f32x4 acc[4];
#pragma unroll
        for (int mb = 0; mb < 4; ++mb) acc[mb] = (f32x4){0.f, 0.f, 0.f, 0.f};
#pragma unroll
        for (int sub = 0; sub < 8; ++sub) {
            const f32x4 d = MFMA16(__builtin_bit_cast(bf16x4, uall[sub]), ident, ((f32x4){0.f, 0.f, 0.f, 0.f}));
            v2u utw; utw.x = pk2(d[0], d[1]); utw.y = pk2(d[2], d[3]);
            const bf16x4 ut = __builtin_bit_cast(bf16x4, utw);
#pragma unroll
            for (int mb = 0; mb < 4; ++mb) acc[mb] = MFMA16(tab[sub][mb], ut, acc[mb]);
        }
        float v[16];
#pragma unroll
        for (int j = 0; j < 8; ++j) { const float wr = acc[j >> 1][2 * (j & 1)], wi = acc[j >> 1][2 * (j & 1) + 1];
            v[2 * j] = bre[j] * wr - bim[j] * wi; v[2 * j + 1] = bre[j] * wi + bim[j] * wr; }
#pragma unroll
        for (int i = 0; i < 8; ++i) { const bool up = (fr & 8) != 0; const float send = up ? v[i] : v[8 + i], keep = up ? v[8 + i] : v[i]; v[i] = keep + SWZX(send, 0x201F); }
#pragma unroll
        for (int i = 0; i < 4; ++i) { const bool up = (fr & 4) != 0; const float send = up ? v[i] : v[4 + i], keep = up ? v[4 + i] : v[i]; v[i] = keep + SWZX(send, 0x101F); }
#pragma unroll
        for (int i = 0; i < 2; ++i) { const bool up = (fr & 2) != 0; const float send = up ? v[i] : v[2 + i], keep = up ? v[2 + i] : v[i]; v[i] = keep + SWZX(send, 0x081F); }
        const float sre = v[0] + SWZX(v[0], 0x041F), sim = v[1] + SWZX(v[1], 0x041F);
        const int j = fr >> 1, p = 8 * (4 * half + (j >> 1)) + 2 * fq + (j & 1);
        if ((fr & 1) == 0) *(GAS f32x2*)(LOC + ((size_t)pc * 8192 + g * SP + p) * 2) = (f32x2){sre, sim};
    }
}
#ifndef RS_PROBE_MODE
#define RS_PROBE_MODE 0
#endif
#ifndef REPU_RETS
#define REPU_RETS 0
#endif
#ifndef REPU_LRU0
#define REPU_LRU0 0
#endif
#ifndef REPU_RSCAN
#define REPU_RSCAN 0
#endif
#ifndef REP_P0
#define REP_P0 0
#endif
#ifndef REP_G1
#define REP_G1 0
#endif
#ifndef REP_MIXA
#define REP_MIXA 0
#endif
#ifndef REP_MIXC
#define REP_MIXC 0
#endif
#ifndef REP_S5A
#define REP_S5A 0
#endif
#ifndef REP_S5C
#define REP_S5C 0
#endif
#ifndef REP_G4
#define REP_G4 0
#endif
#ifndef REP_RMS
#define REP_RMS 0
#endif
#ifdef SKIP_P0
#define DO_P0 0
#else
#define DO_P0 1
#endif
#ifdef SKIP_RETA
#define DO_RETA 0
#else
#define DO_RETA 1
#endif
#ifdef SKIP_LRU0
#define DO_LRU0 0
#else
#define DO_LRU0 1
#endif
#ifdef SKIP_RETS
#define DO_RETS 0
#else
#define DO_RETS 1
#endif
#ifdef SKIP_LRU2
#define DO_LRU2 0
#else
#define DO_LRU2 1
#endif
#ifdef SKIP_BPH
#define DO_BPH 0
#else
#define DO_BPH 1
#endif
#ifdef SKIP_RETC
#define DO_RETC 0
#else
#define DO_RETC 1
#endif
#ifdef SKIP_LRU1
#define DO_LRU1 0
#else
#define DO_LRU1 1
#endif
#ifdef SKIP_S50
#define DO_S50 0
#else
#define DO_S50 1
#endif
#ifdef SKIP_S52
#define DO_S52 0
#else
#define DO_S52 1
#endif
#ifdef SKIP_S51
#define DO_S51 0
#else
#define DO_S51 1
#endif
#ifdef SKIP_S5B
#define DO_S5B 0
#else
#define DO_S5B 1
#endif
#ifdef SKIP_G1
#define DO_G1 0
#else
#define DO_G1 1
#endif
#ifdef SKIP_G2
#define DO_G2 0
#else
#define DO_G2 1
#endif
#ifdef SKIP_G3
#define DO_G3 0
#else
#define DO_G3 1
#endif
#ifdef SKIP_G4
#define DO_G4 0
#else
#define DO_G4 1
#endif
#ifdef SKIP_G5
#define DO_G5 0
#else
#define DO_G5 1
#endif
#ifdef SKIP_RMS
#define DO_RMS 0
#else
#define DO_RMS 1
#endif
struct Args { const float* in[N_IN]; float* out; unsigned char* ws; int ph_lo, ph_hi; };
static_assert(sizeof(Args) == (N_IN + 2) * 8 + 8, "Args has no padding");

__global__ void __launch_bounds__(NTHR, 2) fwd_kernel(Args args) {
    extern __shared__ __attribute__((aligned(16))) unsigned char lds_raw[];
    Frame F;
    F.lds = (LAS unsigned char*)lds_raw;
    F.tid = threadIdx.x; F.lane = F.tid & 63; F.wave = __builtin_amdgcn_readfirstlane(F.tid >> 6);
    F.G = gridDim.x; F.bid = blockIdx.x;
    F.out = (GAS float*)args.out; F.ws = (GAS unsigned char*)args.ws;
    volatile LAS unsigned* MISC = (volatile LAS unsigned*)(F.lds + MISC_OFF);
    for (int u = F.tid; u < (LDS_BYTES - MISC_OFF) / 4; u += NTHR) MISC[u] = 0u;
    __syncthreads();
    const int lo = args.ph_lo, hi = args.ph_hi;
    unsigned* barw = (unsigned*)(F.ws + WS_CTL) + CW_BAR;
    XcdBarrier bar; bar.bar = barw; bar.x = 0; bar.st = nullptr;
    if (hi - lo > 1) bar = xcd_barrier_post(barw, MISC + 8);
#define IN(k) (lo <= (k) && (k) < hi)
#ifndef REP_BAR
#define REP_BAR 0
#endif
#define SEAM(k) do { if (IN(k) && IN((k) + 1)) { for (int rb = 0; rb <= REP_BAR; ++rb) xcd_barrier(bar, F.tid); } } while (0)
#define LAUNDER() do { asm volatile("" : "+s"(F.ws), "+s"(F.out), "+s"(F.bid), "+v"(F.tid), "+v"(F.lane)); F.wave = __builtin_amdgcn_readfirstlane(F.tid >> 6); } while (0)
    const int gw = F.bid * NWAVES + F.wave, NGW = F.G * NWAVES;

    if (DO_P0 && IN(0)) { for (int rep = 0; rep <= REP_P0; ++rep) { LAUNDER(); p0_prologue(F); } }

    SEAM(0);

#pragma unroll 1
    for (int layer = 0; layer < 4; ++layer) {
        const int base = 1 + 9 * layer, el = layer >> 1;
        if (!(layer & 1)) {
            if (IN(base + 0)) { LAUNDER();
                pg8::Gemm g{(const GAS bf16*)(F.ws + WS_XN), (const GAS bf16*)(F.ws + WS_WIN + el * SZ_WIN), M, INW, D}; pg8::StaticOrder S; S.init(M, INW, F.G, F.bid, D / 64);
                pg8::EpiStoreBf16 E{(GAS bf16*)(F.ws + WS_PROJ), INW};

                for (int rep = 0; rep <= REP_G1; ++rep) { if (DO_G1) pg8::gemm_phase<pg8::EpiStoreBf16, pg8::StaticOrder, true, true>(F.lds, g, S, E, F.tid); }
                LAUNDER(); if (el == 0) conv_in_tail(F, CV_E0, CV_E3, (M / 256) * (INW / 256) - 3 * F.G); else conv_in_tail(F, CV_E7, CV_E10, (M / 256) * (INW / 256) - 3 * F.G);

            }
            SEAM(base + 0);
            if (IN(base + 1)) for (int rep = 0; rep <= REP_MIXA; ++rep) { LAUNDER();
#pragma unroll 1
                for (int st = 0; st < 2; ++st) {
                    LAUNDER();
                    if ((st ^ (F.bid & 1)) == 0) {
                        if (DO_RETA)
#pragma unroll 1
                        for (int rp = 0; rp <= REPU_RSCAN; ++rp) for (int u0 = F.bid; u0 < 256; u0 += F.G) { const int u = ((u0 & 7) << 5) | (u0 >> 3); ret_scan_unit(F, el, u >> 6, (u >> 4) & 3, (u >> 2) & 3, u & 3); }
                        LAUNDER();
                        if (DO_LRU0)
#pragma unroll 1
                        for (int rp = 0; rp <= REPU_LRU0; ++rp) for (int u = F.bid; u < 512; u += F.G) lru_unit<0>(F, el, u >> 7, (u >> 3) & 15, u & 7, u == F.bid || (F.G & 7) != 0);
                    } else {
                        if (DO_RETS)
#pragma unroll 1
                        for (int rp = 0; rp <= REPU_RETS; ++rp) for (int u = F.bid; u < 512; u += F.G) { if (rp < REPU_RETS) ret_s_unit<RS_PROBE_MODE>(F, el, u >> 2, u & 3); else ret_s_unit<0>(F, el, u >> 2, u & 3); }
                        LAUNDER();
                        if (DO_LRU2)
#pragma unroll 1
                        for (int u = F.bid; u < 32; u += F.G) lru_unit<2>(F, el, 0, u >> 3, u & 7, true);
                    }
                }
            }
            SEAM(base + 1);

            if (IN(base + 3)) for (int rep = 0; rep <= REP_MIXC; ++rep) { LAUNDER();
                LAUNDER();
                if (DO_RETC)
#pragma unroll 1
                for (int u = F.bid; u < 256; u += F.G) ret_c_unit(F, u >> 6, (u >> 4) & 3, u & 15);

                LAUNDER();

                if (DO_LRU1)
#pragma unroll 1
                for (int u = F.bid; u < 512; u += F.G) lru_unit<1>(F, el, u >> 7, (u >> 3) & 15, u & 7, u == F.bid || (F.G & 7) != 0);

            }
            SEAM(base + 3);
            if (IN(base + 4)) { LAUNDER();
                pg8::Gemm g{(const GAS bf16*)(F.ws + WS_CAT), (const GAS bf16*)(F.ws + WS_WOUT + el * SZ_WOUT), M, D, D}; pg8::TailOrder S; S.init(MP, MS / 256, D, F.G, F.bid, D / 64, S_OUT);
                pg8::EpiResid E{(GAS float*)(F.ws + WS_X), D, (GAS float*)(F.ws + WS_SLAB), MP, MS};

            if (DO_G2) pg8::gemm_phase<pg8::EpiResid, pg8::TailOrder, true, true>(F.lds, g, S, E, F.tid);
            LAUNDER(); if (el == 0) conv_in_tail(F, CV_E3, CV_T2E, (MS / 256) * (D / 256) * S_OUT); else conv_in_tail(F, CV_E10, CV_T7E, (MS / 256) * (D / 256) * S_OUT);
#ifdef REP_G2
            { pg8::EpiResid E2{(GAS float*)(F.ws + WS_PROJ), D, (GAS float*)(F.ws + WS_SLAB), MP, MS}; for (int rep = 0; rep < REP_G2; ++rep) pg8::gemm_phase<pg8::EpiResid, pg8::TailOrder, true, true>(F.lds, g, S, E2, F.tid); }
#endif

            }
            SEAM(base + 4);
        } else {
            if (IN(base + 1)) for (int rep = 0; rep <= REP_S5A; ++rep) { LAUNDER();
                LAUNDER();
                if (DO_S50)
#pragma unroll 1
                for (int wu = gw; wu < 2048; wu += NGW) s5_end_units(F, el, wu & 127, (wu >> 7) & 1, wu >> 8, 8);

                LAUNDER();

                if (DO_S52)
#pragma unroll 1
                for (int u = gw; u < 32 * SG; u += NGW) s5_wave_unit<2>(F, el, 0, u >> 7, u & 127);

            }
            SEAM(base + 1);
            if (IN(base + 3)) for (int rep = 0; rep <= REP_S5C; ++rep) { LAUNDER();
                LAUNDER();
                if (DO_S51)
#pragma unroll 1
                for (int u = gw; u < BATCH * NCH * SG; u += NGW) s5_wave_unit<1>(F, el, u >> 11, (u >> 7) & 15, u & 127);

            }
            SEAM(base + 3);
            if (IN(base + 4)) { LAUNDER();
                pg8::Gemm g{(const GAS bf16*)(F.ws + WS_CAT), (const GAS bf16*)(F.ws + WS_WGLU + el * SZ_WGLU), M, 2 * D, D}; pg8::TailOrder S; S.init(MP, MS / 256, 2 * D, F.G, F.bid, D / 64, S_GLU);
                pg8::EpiGluResid E{(GAS float*)(F.ws + WS_X), D, F.inp(I_BGLU) + (size_t)el * 2 * D, D, (GAS float*)(F.ws + WS_SLAB), MP, MS};

                if (DO_G3) pg8::gemm_phase<pg8::EpiGluResid, pg8::TailOrder, true, true>(F.lds, g, S, E, F.tid);

            }
            SEAM(base + 4);
        }
        if (DO_RMS && IN(base + 5)) { LAUNDER(); if (layer & 1) rms_phase(F, 0, nullptr, 2, S_GLU, F.inp(I_BGLU) + (size_t)el * 2 * D); else rms_phase(F, 0, nullptr, 1, S_OUT, nullptr); }
        SEAM(base + 5);
        if (IN(base + 6)) { LAUNDER();
            pg8::Gemm g{(const GAS bf16*)(F.ws + WS_XN), (const GAS bf16*)(F.ws + WS_WGU + layer * SZ_WGU), M, 2 * FF, D}; pg8::StaticOrder S; S.init(M, 2 * FF, F.G, F.bid, D / 64);
            pg8::EpiSwiglu E{(GAS bf16*)(F.ws + WS_H), FF};

            for (int rep = 0; rep <= REP_G4; ++rep) { if (DO_G4) pg8::gemm_phase<pg8::EpiSwiglu, pg8::StaticOrder, true, true>(F.lds, g, S, E, F.tid); }
            LAUNDER(); { const int nb = (M / 256) * (2 * FF / 256) - 5 * F.G;
              if (layer == 0) conv_in_tail(F, CV_T2E, CV_T3E, nb); else if (layer == 1) conv_in_tail(F, CV_E6, CV_T5E, nb); else if (layer == 2) conv_in_tail(F, CV_T7E, CV_T8E, nb); }

        }
        SEAM(base + 6);
        if (IN(base + 7)) { LAUNDER();
            pg8::Gemm g{(const GAS bf16*)(F.ws + WS_H), (const GAS bf16*)(F.ws + WS_WDN + layer * SZ_WDN), M, D, FF}; pg8::TailOrder S; S.init(MP, MS / 256, D, F.G, F.bid, FF / 64, S_DN);
            pg8::EpiResid E{(GAS float*)(F.ws + WS_X), D, (GAS float*)(F.ws + WS_SLAB), MP, MS};

            if (DO_G5) pg8::gemm_phase<pg8::EpiResid, pg8::TailOrder, true, true>(F.lds, g, S, E, F.tid);
            LAUNDER(); { const int nb = (MS / 256) * (D / 256) * S_DN;
              if (layer == 0) conv_in_tail(F, CV_T3E, CV_T4E, nb); else if (layer == 1) conv_in_tail(F, CV_T5E, CV_E7, nb); else if (layer == 2) conv_in_tail(F, CV_T8E, CV_T9E, nb); }
#ifdef REP_G5
            { pg8::EpiResid E2{(GAS float*)(F.ws + WS_PROJ), D, (GAS float*)(F.ws + WS_SLAB), MP, MS}; for (int rep = 0; rep < REP_G5; ++rep) pg8::gemm_phase<pg8::EpiResid, pg8::TailOrder, true, true>(F.lds, g, S, E2, F.tid); }
#endif

        }
        SEAM(base + 7);
        if (DO_RMS && IN(base + 8)) { LAUNDER();
            if (layer == 3) { rms_phase(F, 2, F.inp(I_NFIN), 1, S_DN, nullptr); }
            else if (!(layer & 1)) { rms_phase(F, 1, F.inp(I_NMO) + (size_t)el * D, 1, S_DN, nullptr); }
            else { rms_phase(F, 0, nullptr, 1, S_DN, nullptr); }
        }
        if (layer < 3) SEAM(base + 8);
    }
#undef IN
#undef SEAM
#undef LAUNDER
}

extern "C" void kernel_launch(void* const* d_in, const int* in_sizes, int n_in, void* d_out, int out_size, void* d_ws, size_t ws_size, hipStream_t stream) {
    static int grid = 0;
    if (grid == 0) {
        if (n_in != N_IN || (size_t)out_size != O_END || ws_size < WS_END) { fprintf(stderr, "kernel_launch: unexpected sizes: n_in %d out %d ws %zu (need %d, %zu, >= %zu)\n", n_in, out_size, ws_size, (int)N_IN, (size_t)O_END, (size_t)WS_END); grid = -1; return; }
        int dev = 0, cus = 0, per_cu = 0;
        if (hipGetDevice(&dev) != hipSuccess || hipDeviceGetAttribute(&cus, hipDeviceAttributeMultiprocessorCount, dev) != hipSuccess) { grid = -1; return; }
        if (hipFuncSetAttribute((const void*)fwd_kernel, hipFuncAttributeMaxDynamicSharedMemorySize, LDS_BYTES) != hipSuccess) { fprintf(stderr, "kernel_launch: hipFuncSetAttribute failed\n"); grid = -1; return; }
        if (hipOccupancyMaxActiveBlocksPerMultiprocessor(&per_cu, (const void*)fwd_kernel, NTHR, LDS_BYTES) != hipSuccess || per_cu < 1) { fprintf(stderr, "kernel_launch: occupancy query says %d blocks per CU\n", per_cu); (void)hipGetLastError(); grid = -1; return; }
        grid = cus;
    }
    if (grid < 0) return;
    if (hipMemsetAsync((char*)d_ws + WS_CTL, 0, CTL_ZERO_BYTES, stream) != hipSuccess) return;
    Args a{};
    for (int i = 0; i < N_IN; ++i) a.in[i] = (const float*)d_in[i];
    a.out = (float*)d_out; a.ws = (unsigned char*)d_ws;
#if MK_ONE_LAUNCH
    a.ph_lo = 0; a.ph_hi = NPHASE;
    hipLaunchKernelGGL(fwd_kernel, dim3(grid), dim3(NTHR), LDS_BYTES, stream, a);
#else
    for (int ph = 0; ph < NPHASE; ++ph) {
        if (ph >= 1 && ((ph - 1) % 9) == 0 && (((ph - 1) / 9) & 1)) continue;
        if (ph >= 1 && ((ph - 1) % 9) == 2) continue;
        a.ph_lo = ph; a.ph_hi = ph + 1;
        hipLaunchKernelGGL(fwd_kernel, dim3(grid), dim3(NTHR), LDS_BYTES, stream, a);
    }
#endif
}
```
